# Optimizing an MI355X kernel written in HIP

```python
import jax, jax.numpy as jnp
from jax import lax
import numpy as np

D_MODEL = 1024
BATCH = 1
SEQ = 16384
DEPTH = 4

CHUNK = 64
HEAD_DIM = 64
N_HEADS_SB = 4
N_HEADS_CH = 8
CONV_CH = 256
CONV_WIDTH = 3
N_PREV_CHUNKS = 8
BAND = (N_PREV_CHUNKS + 1) * CHUNK
REL_CLIP = 128
Q_BLOCK = 128
D_SB = N_HEADS_SB * HEAD_DIM
D_CH = N_HEADS_CH * HEAD_DIM
D_MIX = D_SB + D_CH + CONV_CH
D_IN = 3 * D_SB + 3 * D_CH + 3 * CONV_CH
N_OUT_GROUPS = D_MIX // HEAD_DIM
D_FF = ((8 * D_MODEL // 3 + 255) // 256) * 256
EPS = 1e-6

kernel_name = "hybrid_stickbreak_chunkattn_shortconv_block"


def rmsnorm(x, w):
    xf = x.astype(jnp.float32)
    y = xf * lax.rsqrt(jnp.mean(xf * xf, axis=-1, keepdims=True) + EPS)
    return (y * w.astype(jnp.float32)).astype(x.dtype)


def group_rmsnorm(y, w):
    b, s, _ = y.shape
    yg = y.astype(jnp.float32).reshape(b, s, N_OUT_GROUPS, HEAD_DIM)
    yg = yg * lax.rsqrt(jnp.mean(yg * yg, axis=-1, keepdims=True) + EPS)
    return (yg.reshape(b, s, D_MIX) * w.astype(jnp.float32)).astype(y.dtype)


def to_heads(t):
    b, s, _ = t.shape
    return t.reshape(b, s, -1, HEAD_DIM).transpose(0, 2, 1, 3)


def from_heads(t):
    b, h, s, d = t.shape
    return t.transpose(0, 2, 1, 3).reshape(b, s, h * d)


def stick_breaking_attention(q, k, v):
    b, h, s, d = q.shape
    n = s // Q_BLOCK
    qb = (q.astype(jnp.float32) * (d ** -0.5)).reshape(b, h, n, Q_BLOCK, d)
    kb = k.astype(jnp.float32).reshape(b, h, n, Q_BLOCK, d)
    vb = v.astype(jnp.float32).reshape(b, h, n, Q_BLOCK, d)
    idx = jnp.arange(Q_BLOCK)
    after_mat = (idx[:, None] > idx[None, :]).astype(jnp.float32)
    diag_mask = idx[None, :] < idx[:, None]
    out = jnp.zeros((b, h, n, Q_BLOCK, d), jnp.float32)
    carry = jnp.zeros((b, h, n, Q_BLOCK), jnp.float32)
    for o in range(n):
        z = jnp.einsum('bhnqd,bhnkd->bhnqk', qb[:, :, o:], kb[:, :, :n - o])
        log_rest = jax.nn.log_sigmoid(-z)
        if o == 0:
            log_rest = jnp.where(diag_mask, log_rest, 0.0)
        after = jnp.einsum('bhnqj,js->bhnqs', log_rest, after_mat) + carry[:, :, o:, :, None]
        w = jnp.exp(jax.nn.log_sigmoid(z) + after)
        if o == 0:
            w = jnp.where(diag_mask, w, 0.0)
        out = out.at[:, :, o:].add(jnp.einsum('bhnqk,bhnkd->bhnqd', w, vb[:, :, :n - o]))
        carry = carry.at[:, :, o:].add(jnp.sum(log_rest, axis=-1))
    return out.reshape(b, h, s, d).astype(v.dtype)


def chunked_relpos_attention(q, k, v, rel_bias):
    b, h, s, d = q.shape
    nc = s // CHUNK
    pad = N_PREV_CHUNKS * CHUNK
    qc = (q.astype(jnp.float32) * (d ** -0.5)).reshape(b, h, nc, CHUNK, d)
    kpad = jnp.pad(k, ((0, 0), (0, 0), (pad, 0), (0, 0))).reshape(b, h, nc + N_PREV_CHUNKS, CHUNK, d)
    vpad = jnp.pad(v, ((0, 0), (0, 0), (pad, 0), (0, 0))).reshape(b, h, nc + N_PREV_CHUNKS, CHUNK, d)
    band_idx = jnp.arange(nc)[:, None] + jnp.arange(N_PREV_CHUNKS + 1)[None, :]
    kb = kpad[:, :, band_idx].reshape(b, h, nc, BAND, d).astype(jnp.float32)
    vb = vpad[:, :, band_idx].reshape(b, h, nc, BAND, d).astype(jnp.float32)
    scores = jnp.einsum('bhcqd,bhckd->bhcqk', qc, kb)
    p = jnp.arange(CHUNK)[:, None]
    m = jnp.arange(BAND)[None, :]
    rel = jnp.clip(N_PREV_CHUNKS * CHUNK + p - m, -REL_CLIP, REL_CLIP) + REL_CLIP
    bias = rel_bias.astype(jnp.float32)[:, rel]
    valid = jnp.repeat(band_idx >= N_PREV_CHUNKS, CHUNK, axis=1)
    scores = jnp.where(valid[None, None, :, None, :], scores + bias[None, :, None], -jnp.inf)
    probs = jax.nn.softmax(scores, axis=-1)
    out = jnp.einsum('bhcqk,bhckd->bhcqd', probs, vb)
    return out.reshape(b, h, s, d).astype(v.dtype)


def short_conv_mixer(gate_b, gate_c, xc, conv_w):
    hc = gate_c * xc
    y = lax.conv_general_dilated(
        hc, conv_w[:, None, :].astype(hc.dtype), window_strides=(1,),
        padding=[(CONV_WIDTH - 1, 0)], dimension_numbers=('NWC', 'WIO', 'NWC'),
        feature_group_count=CONV_CH)
    return gate_b * y


def swiglu(x, w_gate, w_up, w_down):
    return (jax.nn.silu(x @ w_gate) * (x @ w_up)) @ w_down


def setup_inputs(seed: int = 0) -> dict:
    key = jax.random.key(seed)
    ks = jax.random.split(key, 14)
    f32 = jnp.float32

    def gain(k, n):
        return 1.0 + 0.02 * jax.random.normal(k, (DEPTH, n), f32)

    return {
        "x": jax.random.normal(ks[0], (BATCH, SEQ, D_MODEL), f32),
        "attn_norm_w": gain(ks[1], D_MODEL),
        "w_in": jax.random.normal(ks[2], (DEPTH, D_MODEL, D_IN), f32) * D_MODEL ** -0.5,
        "q_norm_w": gain(ks[3], HEAD_DIM),
        "k_norm_w": gain(ks[4], HEAD_DIM),
        "rel_bias": 0.1 * jax.random.normal(ks[5], (DEPTH, N_HEADS_CH, 2 * REL_CLIP + 1), f32),
        "conv_w": jax.random.normal(ks[6], (DEPTH, CONV_WIDTH, CONV_CH), f32) * CONV_WIDTH ** -0.5,
        "out_norm_w": gain(ks[7], D_MIX),
        "w_out": jax.random.normal(ks[8], (DEPTH, D_MIX, D_MODEL), f32) * D_MIX ** -0.5,
        "ffn_norm_w": gain(ks[9], D_MODEL),
        "w_gate": jax.random.normal(ks[10], (DEPTH, D_MODEL, D_FF), f32) * D_MODEL ** -0.5,
        "w_up": jax.random.normal(ks[11], (DEPTH, D_MODEL, D_FF), f32) * D_MODEL ** -0.5,
        "w_down": jax.random.normal(ks[12], (DEPTH, D_FF, D_MODEL), f32) * D_FF ** -0.5,
    }


def reference(x, attn_norm_w, w_in, q_norm_w, k_norm_w, rel_bias, conv_w, out_norm_w,
              w_out, ffn_norm_w, w_gate, w_up, w_down):
    widths = [D_SB] * 3 + [D_CH] * 3 + [CONV_CH] * 3
    split_points = [int(v) for v in np.cumsum(widths)[:-1]]
    for l in range(DEPTH):
        h = rmsnorm(x, attn_norm_w[l])
        proj = h @ w_in[l]
        (q_a, k_a, v_a, q_b, k_b, v_b, g_b, g_c, x_c) = jnp.split(proj, split_points, axis=-1)
        y_sb = from_heads(stick_breaking_attention(to_heads(q_a), to_heads(k_a), to_heads(v_a)))
        qh = rmsnorm(to_heads(q_b), q_norm_w[l])
        kh = rmsnorm(to_heads(k_b), k_norm_w[l])
        y_ch = from_heads(chunked_relpos_attention(qh, kh, to_heads(v_b), rel_bias[l]))
        y_cv = short_conv_mixer(g_b, g_c, x_c, conv_w[l])
        y = group_rmsnorm(jnp.concatenate([y_sb, y_ch, y_cv], axis=-1), out_norm_w[l])
        x = x + y @ w_out[l]
        x = x + swiglu(rmsnorm(x, ffn_norm_w[l]), w_gate[l], w_up[l], w_down[l])
    return x
```

```cpp
#include <hip/hip_runtime.h>
#include <stdint.h>
#include <cstdio>

constexpr int S = 16384, DM = 1024, DIN = 3072, DFF = 2816, DEPTH = 4;
constexpr float EPS = 1e-6f;
typedef unsigned short bf16_t;
typedef short bf16x8 __attribute__((ext_vector_type(8)));
typedef float f32x16 __attribute__((ext_vector_type(16)));
typedef float f32x4 __attribute__((ext_vector_type(4)));

constexpr size_t WS_WIN = 0, WS_WOUT = 25165824, WS_WGU = 33554432, WS_WDN = 79691776, WS_XB = 102760448, WS_Y = 136314880,
                 WS_RSS = 169869312, WS_PROJ = 170917888, WS_END = 271581184;

struct P {
    const float *x, *attn_norm_w, *w_in, *q_norm_w, *k_norm_w, *rel_bias, *conv_w, *out_norm_w, *w_out, *ffn_norm_w, *w_gate, *w_up, *w_down;
    float* out;
    bf16_t *wt_in, *wt_out, *wt_gu, *wt_dn, *xb, *proj, *y, *hid;
    float* rowss;
};

__device__ __forceinline__ unsigned f2bf(float f) { unsigned u = __float_as_uint(f); return (u + 0x7fffu + ((u >> 16) & 1u)) >> 16; }
__device__ __forceinline__ float bf2f(bf16_t b) { return __uint_as_float(((unsigned)b) << 16); }
__device__ __forceinline__ float wave_sum(float v) {
#pragma unroll
    for (int o = 1; o < 64; o <<= 1) v += __shfl_xor(v, o);
    return v;
}
__device__ __forceinline__ float wave_max(float v) {
#pragma unroll
    for (int o = 1; o < 64; o <<= 1) v = fmaxf(v, __shfl_xor(v, o));
    return v;
}
__device__ __forceinline__ int crow(int r, int hi) { return (r & 3) + 8 * (r >> 2) + 4 * hi; }
__device__ __forceinline__ float row_rstd(const float* rowss, int row) {
    const f32x4* q = (const f32x4*)(rowss + (size_t)row * 16);
    f32x4 a = q[0], b = q[1], c = q[2], d = q[3];
    float s = ((a.x + a.y) + (a.z + a.w)) + ((b.x + b.y) + (b.z + b.w)) + ((c.x + c.y) + (c.z + c.w)) + ((d.x + d.y) + (d.z + d.w));
    return rsqrtf(s * (1.0f / DM) + EPS);
}

__device__ __forceinline__ void conv_tile(const float* __restrict__ W, int N, const float* gain, bf16_t* Wt, int K, int dst_row0, int k0, int n0,
                                          float* tile, int tid, int nthr) {
    for (int i = tid; i < 4096; i += nthr) {
        int kk = i >> 6, nn = i & 63;
        float v = W[(size_t)(k0 + kk) * N + n0 + nn];
        if (gain) v *= gain[k0 + kk];
        tile[kk * 65 + nn] = v;
    }
    __syncthreads();
    for (int i = tid; i < 2048; i += nthr) {
        int nn = i >> 5, kp = i & 31;
        unsigned lo = f2bf(tile[(2 * kp) * 65 + nn]), hi = f2bf(tile[(2 * kp + 1) * 65 + nn]);
        *(unsigned*)(Wt + (size_t)(dst_row0 + nn) * K + k0 + 2 * kp) = lo | (hi << 16);
    }
    __syncthreads();
}
constexpr int T_IN = 16 * 48, T_OUT = 16 * 16, T_G = 16 * 44, T_DN = 44 * 16, T_LAYER = T_IN + T_OUT + 2 * T_G + T_DN, T_ALL = DEPTH * T_LAYER;
__device__ __forceinline__ void conv_item(const P& p, int item, float* tile, int tid, int nthr) {
    int l = item / T_LAYER, r = item % T_LAYER;
    if (r < T_IN) { int kb = r / 48, nb = r % 48;
        conv_tile(p.w_in + (size_t)l * DM * DIN, DIN, p.attn_norm_w + l * DM, p.wt_in + (size_t)l * DIN * DM, DM, nb * 64, kb * 64, nb * 64, tile, tid, nthr); return; }
    r -= T_IN;
    if (r < T_OUT) { int kb = r / 16, nb = r % 16;
        conv_tile(p.w_out + (size_t)l * DM * DM, DM, nullptr, p.wt_out + (size_t)l * DM * DM, DM, nb * 64, kb * 64, nb * 64, tile, tid, nthr); return; }
    r -= T_OUT;
    if (r < 2 * T_G) { int up = r >= T_G; if (up) r -= T_G; int kb = r / 44, nb = r % 44; int n0 = nb * 64;
        int dst = 256 * (n0 / 128) + (n0 % 128) + (up ? 128 : 0);
        conv_tile((up ? p.w_up : p.w_gate) + (size_t)l * DM * DFF, DFF, p.ffn_norm_w + l * DM, p.wt_gu + (size_t)l * 2 * DFF * DM, DM, dst, kb * 64, n0, tile, tid, nthr); return; }
    r -= 2 * T_G;
    { int kb = r / 16, nb = r % 16;
        conv_tile(p.w_down + (size_t)l * DFF * DM, DM, nullptr, p.wt_dn + (size_t)l * DM * DFF, DFF, nb * 64, kb * 64, nb * 64, tile, tid, nthr); }
}
__global__ __launch_bounds__(256) void k_prep(P p) {
    __shared__ float tile[64 * 65];
    for (int it = blockIdx.x; it < T_ALL; it += gridDim.x) conv_item(p, it, tile, threadIdx.x, 256);
}

__device__ __forceinline__ void row_to_bf16_stats(const float* src, bf16_t* xb, float* rowss, int row, int lane) {
    const f32x4* xr = (const f32x4*)(src + (size_t)row * DM) + lane;
    unsigned long long* o8 = (unsigned long long*)(xb + (size_t)row * DM) + lane;
    float s = 0.f;
#pragma unroll
    for (int j = 0; j < 4; ++j) {
        f32x4 v = xr[64 * j];
        s += (v.x * v.x + v.y * v.y) + (v.z * v.z + v.w * v.w);
        o8[64 * j] = (unsigned long long)(f2bf(v.x) | (f2bf(v.y) << 16)) | ((unsigned long long)(f2bf(v.z) | (f2bf(v.w) << 16)) << 32);
    }
    s = wave_sum(s);
    if (lane < 16) rowss[(size_t)row * 16 + lane] = lane == 0 ? s : 0.f;
}
__global__ __launch_bounds__(256) void k_rowstats(P p, const float* src) {
    int w = blockIdx.x * 4 + (threadIdx.x >> 6);
    row_to_bf16_stats(src, p.xb, p.rowss, w, threadIdx.x & 63);
}

template <int MODE> __global__ __launch_bounds__(256) void k_gemm(P p, int l) {
    const int wave = threadIdx.x >> 6, lane = threadIdx.x & 63, r32 = lane & 31, hi = lane >> 5;
    constexpr int N = MODE == 1 ? DIN : MODE == 3 ? DFF : DM;
    constexpr int K = MODE == 4 ? DFF : DM;
    constexpr int nbn = N / 64;
    const int bm = blockIdx.x / nbn, bn = blockIdx.x % nbn;
    const int m0 = bm * 64 + (wave >> 1) * 32, n0 = bn * 64 + (wave & 1) * 32;
    const bf16_t* A = (MODE == 1 || MODE == 3) ? p.xb : MODE == 2 ? p.y : p.hid;
    const bf16_t* Bt; int brow0 = n0;
    if (MODE == 1) Bt = p.wt_in + (size_t)l * DIN * DM;
    else if (MODE == 2) Bt = p.wt_out + (size_t)l * DM * DM;
    else if (MODE == 3) { Bt = p.wt_gu + (size_t)l * 2 * DFF * DM; brow0 = 256 * (n0 / 128) + (n0 % 128); }
    else Bt = p.wt_dn + (size_t)l * DM * DFF;
    f32x16 acc0, acc1;
#pragma unroll
    for (int i = 0; i < 16; ++i) { acc0[i] = 0.f; acc1[i] = 0.f; }
    const bf16_t* ap = A + (size_t)(m0 + r32) * K + 8 * hi;
    const bf16_t* bp0 = Bt + (size_t)(brow0 + r32) * K + 8 * hi;
    const bf16_t* bp1 = bp0 + (size_t)128 * K;
    for (int k = 0; k < K; k += 16) {
        bf16x8 a = *(const bf16x8*)(ap + k), b = *(const bf16x8*)(bp0 + k);
        acc0 = __builtin_amdgcn_mfma_f32_32x32x16_bf16(a, b, acc0, 0, 0, 0);
        if (MODE == 3) { bf16x8 b1 = *(const bf16x8*)(bp1 + k); acc1 = __builtin_amdgcn_mfma_f32_32x32x16_bf16(a, b1, acc1, 0, 0, 0); }
    }
    const int col = n0 + r32;
#pragma unroll
    for (int i = 0; i < 16; ++i) {
        const int row = m0 + crow(i, hi);
        if (MODE == 1) { float rs = row_rstd(p.rowss, row); p.proj[(size_t)row * DIN + col] = (bf16_t)f2bf(acc0[i] * rs); }
        else if (MODE == 3) { float rs = row_rstd(p.rowss, row); float g = acc0[i] * rs, u = acc1[i] * rs;
            float sg = g / (1.f + __expf(-g)); p.hid[(size_t)row * DFF + col] = (bf16_t)f2bf(sg * u); }
        else { const float* base = (MODE == 2 && l == 0) ? p.x : p.out; size_t o = (size_t)row * DM + col; p.out[o] = base[o] + acc0[i]; }
    }
}

__global__ __launch_bounds__(256) void k_mixC(P p, int l) {
    const int w = blockIdx.x * 4 + (threadIdx.x >> 6), t = w >> 2, g = w & 3, lane = threadIdx.x & 63, c = g * 64 + lane;
    const bf16_t* pr = p.proj; const float* cw = p.conv_w + l * 3 * 256;
    float acc = 0.f;
#pragma unroll
    for (int j = 0; j < 3; ++j) { int tt = t - 2 + j;
        if (tt >= 0) { float gc = bf2f(pr[(size_t)tt * DIN + 2560 + c]), xc = bf2f(pr[(size_t)tt * DIN + 2816 + c]); acc += cw[j * 256 + c] * (gc * xc); } }
    float yv = bf2f(pr[(size_t)t * DIN + 2304 + c]) * acc;
    float ss = wave_sum(yv * yv);
    float o = yv * rsqrtf(ss * (1.f / 64) + EPS) * p.out_norm_w[l * DM + 768 + c];
    p.y[(size_t)t * DM + 768 + c] = (bf16_t)f2bf(o);
}

__global__ __launch_bounds__(64) void k_mixB(P p, int l) {
    __shared__ float qs[64]; __shared__ float gks[64]; __shared__ float sc[576];
    const int t = blockIdx.x >> 3, h = blockIdx.x & 7, lane = threadIdx.x;
    const bf16_t* pr = p.proj;
    float q = bf2f(pr[(size_t)t * DIN + 768 + h * 64 + lane]);
    float ss = wave_sum(q * q);
    qs[lane] = q * rsqrtf(ss * (1.f / 64) + EPS) * p.q_norm_w[l * 64 + lane] * 0.125f;
    gks[lane] = p.k_norm_w[l * 64 + lane];
    __syncthreads();
    const int c = t >> 6, pq = t & 63;
    const float* rb = p.rel_bias + (size_t)(l * 8 + h) * 257;
    float sv[9]; float mx = -INFINITY;
#pragma unroll
    for (int i = 0; i < 9; ++i) {
        const int m = i * 64 + lane, kt = (c - 8) * 64 + m;
        float s = -INFINITY;
        if (kt >= 0) {
            const bf16_t* kr = pr + (size_t)kt * DIN + 1280 + h * 64;
            float dot = 0.f, ssk = 0.f;
            for (int d8 = 0; d8 < 8; ++d8) { bf16x8 kv = *(const bf16x8*)(kr + d8 * 8);
#pragma unroll
                for (int j = 0; j < 8; ++j) { float kf = bf2f((bf16_t)kv[j]); ssk += kf * kf; dot += qs[d8 * 8 + j] * gks[d8 * 8 + j] * kf; } }
            s = dot * rsqrtf(ssk * (1.f / 64) + EPS);
            int rel = 512 + pq - m; rel = min(max(rel, -128), 128) + 128;
            s += rb[rel];
        }
        sv[i] = s; mx = fmaxf(mx, s);
    }
    mx = wave_max(mx);
    float sum = 0.f;
#pragma unroll
    for (int i = 0; i < 9; ++i) { sv[i] = __expf(sv[i] - mx); sum += sv[i]; }
    sum = wave_sum(sum);
    const float inv = 1.f / sum;
#pragma unroll
    for (int i = 0; i < 9; ++i) sc[i * 64 + lane] = sv[i] * inv;
    __syncthreads();
    float o = 0.f;
    const int kt0 = (c - 8) * 64;
    for (int m = (kt0 < 0 ? -kt0 : 0); m < 576; ++m) o += sc[m] * bf2f(pr[(size_t)(kt0 + m) * DIN + 1792 + h * 64 + lane]);
    float so = wave_sum(o * o);
    p.y[(size_t)t * DM + 256 + h * 64 + lane] = (bf16_t)f2bf(o * rsqrtf(so * (1.f / 64) + EPS) * p.out_norm_w[l * DM + 256 + h * 64 + lane]);
}

__global__ __launch_bounds__(64) void k_mixA(P p, int l) {
    __shared__ float qs[64]; __shared__ float wsh[64];
    const int t = blockIdx.x >> 2, h = blockIdx.x & 3, lane = threadIdx.x;
    const bf16_t* pr = p.proj;
    qs[lane] = bf2f(pr[(size_t)t * DIN + h * 64 + lane]) * 0.125f;
    __syncthreads();
    float carry = 0.f, o = 0.f;
    for (int base = t - 1; base >= 0; base -= 64) {
        const int s = base - lane; const bool valid = s >= 0;
        float z = 0.f, L = 0.f;
        if (valid) {
            const bf16_t* kr = pr + (size_t)s * DIN + 256 + h * 64;
            float dot = 0.f;
            for (int d8 = 0; d8 < 8; ++d8) { bf16x8 kv = *(const bf16x8*)(kr + d8 * 8);
#pragma unroll
                for (int j = 0; j < 8; ++j) dot += qs[d8 * 8 + j] * bf2f((bf16_t)kv[j]); }
            z = dot;
            L = -(fmaxf(z, 0.f) + log1pf(__expf(-fabsf(z))));
        }
        float incl = L;
#pragma unroll
        for (int off = 1; off < 64; off <<= 1) { float n = __shfl_up(incl, off); if (lane >= off) incl += n; }
        const float after = carry + incl - L;
        wsh[lane] = valid ? __expf(z + L + after) : 0.f;
        __syncthreads();
        const int nk = min(64, base + 1);
        for (int j = 0; j < nk; ++j) o += wsh[j] * bf2f(pr[(size_t)(base - j) * DIN + 512 + h * 64 + lane]);
        __syncthreads();
        carry += __shfl(incl, 63);
        if (carry < -60.f) break;
    }
    float so = wave_sum(o * o);
    p.y[(size_t)t * DM + h * 64 + lane] = (bf16_t)f2bf(o * rsqrtf(so * (1.f / 64) + EPS) * p.out_norm_w[l * DM + h * 64 + lane]);
}

extern "C" void kernel_launch(void* const* d_in, const int* in_sizes, int n_in, void* d_out, int out_size, void* d_ws, size_t ws_size, hipStream_t stream) {
    if (ws_size < WS_END) { fprintf(stderr, "ws too small: %zu < %zu\n", ws_size, (size_t)WS_END); return; }
    P p{};
    p.x = (const float*)d_in[0]; p.attn_norm_w = (const float*)d_in[1]; p.w_in = (const float*)d_in[2]; p.q_norm_w = (const float*)d_in[3];
    p.k_norm_w = (const float*)d_in[4]; p.rel_bias = (const float*)d_in[5]; p.conv_w = (const float*)d_in[6]; p.out_norm_w = (const float*)d_in[7];
    p.w_out = (const float*)d_in[8]; p.ffn_norm_w = (const float*)d_in[9]; p.w_gate = (const float*)d_in[10]; p.w_up = (const float*)d_in[11];
    p.w_down = (const float*)d_in[12];
    p.out = (float*)d_out;
    char* ws = (char*)d_ws;
    p.wt_in = (bf16_t*)(ws + WS_WIN); p.wt_out = (bf16_t*)(ws + WS_WOUT); p.wt_gu = (bf16_t*)(ws + WS_WGU); p.wt_dn = (bf16_t*)(ws + WS_WDN);
    p.xb = (bf16_t*)(ws + WS_XB); p.y = (bf16_t*)(ws + WS_Y); p.rowss = (float*)(ws + WS_RSS); p.proj = (bf16_t*)(ws + WS_PROJ); p.hid = p.proj;
    k_prep<<<2048, 256, 0, stream>>>(p);
    k_rowstats<<<S / 4, 256, 0, stream>>>(p, p.x);
    for (int l = 0; l < DEPTH; ++l) {
        k_gemm<1><<<(S / 64) * (DIN / 64), 256, 0, stream>>>(p, l);
        k_mixA<<<S * 4, 64, 0, stream>>>(p, l);
        k_mixB<<<S * 8, 64, 0, stream>>>(p, l);
        k_mixC<<<S, 256, 0, stream>>>(p, l);
        k_gemm<2><<<(S / 64) * (DM / 64), 256, 0, stream>>>(p, l);
        k_rowstats<<<S / 4, 256, 0, stream>>>(p, p.out);
        k_gemm<3><<<(S / 64) * (DFF / 64), 256, 0, stream>>>(p, l);
        k_gemm<4><<<(S / 64) * (DM / 64), 256, 0, stream>>>(p, l);
        if (l + 1 < DEPTH) k_rowstats<<<S / 4, 256, 0, stream>>>(p, p.out);
    }
}
```

```cpp
#include <hip/hip_runtime.h>
#include <hip/hip_cooperative_groups.h>
#include <stdint.h>
#include <cstdio>
namespace cg = cooperative_groups;
#define GSYNC() xcd_barrier(bar)

constexpr int S = 16384, DM = 1024, DIN = 3072, DFF = 2816, DEPTH = 4;
constexpr float EPS = 1e-6f;
typedef unsigned short bf16_t;
typedef short bf16x8 __attribute__((ext_vector_type(8)));
typedef float f32x16 __attribute__((ext_vector_type(16)));
typedef float f32x4 __attribute__((ext_vector_type(4)));
typedef unsigned u32x4 __attribute__((ext_vector_type(4)));

constexpr size_t WS_WIN = 0, WS_WOUT = 25165824, WS_WGU = 33554432, WS_WDN = 79691776, WS_XB = 102760448, WS_Y = 136314880,
                 WS_RSS = 169869312, WS_PROJ = 170917888, WS_CTL = 271581184, CTL_BYTES = 16384, WS_END = WS_CTL + CTL_BYTES;

struct P {
    const float *x, *attn_norm_w, *w_in, *q_norm_w, *k_norm_w, *rel_bias, *conv_w, *out_norm_w, *w_out, *ffn_norm_w, *w_gate, *w_up, *w_down;
    float* out;
    bf16_t *wt_in, *wt_out, *wt_gu, *wt_dn, *xb, *proj, *y, *hid;
    float* rowss;
    unsigned* ctl;
    int use_cg_sync, pad_;
};

__device__ __forceinline__ unsigned f2bf(float f) { unsigned u = __float_as_uint(f); return (u + 0x7fffu + ((u >> 16) & 1u)) >> 16; }
__device__ __forceinline__ float bf2f(bf16_t b) { return __uint_as_float(((unsigned)b) << 16); }
__device__ __forceinline__ float wave_sum(float v) {
#pragma unroll
    for (int o = 1; o < 64; o <<= 1) v += __shfl_xor(v, o);
    return v;
}
__device__ __forceinline__ float wave_max(float v) {
#pragma unroll
    for (int o = 1; o < 64; o <<= 1) v = fmaxf(v, __shfl_xor(v, o));
    return v;
}
__device__ __forceinline__ int crow(int r, int hi) { return (r & 3) + 8 * (r >> 2) + 4 * hi; }
#define WAVE_LDS_SYNC() asm volatile("s_waitcnt lgkmcnt(0)" ::: "memory")

__device__ __forceinline__ void conv_tile_wave(const float* __restrict__ W, int N, const float* gain, bf16_t* Wt, int K, int dst_row0, int k0, int n0,
                                               __attribute__((address_space(3))) float* tile, int lane) {
    const int lr = lane >> 3, lc = (lane & 7) * 4;
    f32x4 v[8];
#pragma unroll
    for (int i = 0; i < 8; ++i) v[i] = __builtin_nontemporal_load((const f32x4*)(W + (size_t)(k0 + 8 * i + lr) * N + n0 + lc));
    if (gain) {
#pragma unroll
        for (int i = 0; i < 8; ++i) v[i] = v[i] * gain[k0 + 8 * i + lr];
    }
#pragma unroll
    for (int i = 0; i < 8; ++i) { __attribute__((address_space(3))) float* t = tile + (8 * i + lr) * 33 + lc; t[0] = v[i][0]; t[1] = v[i][1]; t[2] = v[i][2]; t[3] = v[i][3]; }
    WAVE_LDS_SYNC();
    const int nr = lane >> 3, kc = lane & 7;
    const __amdgpu_buffer_rsrc_t wrs = __builtin_amdgcn_make_buffer_rsrc(Wt, 0, 16 * 1024 * 1024, 0x00020000);
#pragma unroll
    for (int it = 0; it < 4; ++it) { const int n = nr + 8 * it; const __attribute__((address_space(3))) float* sp = tile + (8 * kc) * 33 + n;
        u32x4 o; o.x = f2bf(sp[0]) | (f2bf(sp[33]) << 16); o.y = f2bf(sp[66]) | (f2bf(sp[99]) << 16); o.z = f2bf(sp[132]) | (f2bf(sp[165]) << 16); o.w = f2bf(sp[198]) | (f2bf(sp[231]) << 16);
        __builtin_amdgcn_raw_buffer_store_b128(o, wrs, ((unsigned)(dst_row0 + n) * (unsigned)K + (unsigned)(k0 + 8 * kc)) * 2u, 0,   16); }
    WAVE_LDS_SYNC();
}
constexpr int T_IN = 16 * 96, T_OUT = 16 * 32, T_G = 16 * 88, T_DN = 44 * 32, T_LAYER = T_IN + T_OUT + 2 * T_G + T_DN, T_ALL = DEPTH * T_LAYER;
__device__ __forceinline__ void conv_item(const P& p, int item, __attribute__((address_space(3))) float* tile, int lane) {
    int l = item / T_LAYER, r = item % T_LAYER;
    if (r < T_IN) { int kb = r / 96, nb = r % 96;
        conv_tile_wave(p.w_in + (size_t)l * DM * DIN, DIN, p.attn_norm_w + l * DM, p.wt_in + (size_t)l * DIN * DM, DM, nb * 32, kb * 64, nb * 32, tile, lane); return; }
    r -= T_IN;
    if (r < T_OUT) { int kb = r / 32, nb = r % 32;
        conv_tile_wave(p.w_out + (size_t)l * DM * DM, DM, nullptr, p.wt_out + (size_t)l * DM * DM, DM, nb * 32, kb * 64, nb * 32, tile, lane); return; }
    r -= T_OUT;
    if (r < 2 * T_G) { int up = r >= T_G; if (up) r -= T_G; int kb = r / 88, nb = r % 88; int n0 = nb * 32;
        int dst = 256 * (n0 / 128) + (n0 % 128) + (up ? 128 : 0);
        conv_tile_wave((up ? p.w_up : p.w_gate) + (size_t)l * DM * DFF, DFF, p.ffn_norm_w + l * DM, p.wt_gu + (size_t)l * 2 * DFF * DM, DM, dst, kb * 64, n0, tile, lane); return; }
    r -= 2 * T_G;
    { int kb = r / 32, nb = r % 32;
        conv_tile_wave(p.w_down + (size_t)l * DFF * DM, DM, nullptr, p.wt_dn + (size_t)l * DM * DFF, DFF, nb * 32, kb * 64, nb * 32, tile, lane); }
}

namespace pg8 {
#define PG8_LAS __attribute__((address_space(3)))
typedef unsigned short bf16_t;
typedef short bf16x8 __attribute__((ext_vector_type(8)));
typedef float f32x4 __attribute__((ext_vector_type(4)));
typedef unsigned u32x4 __attribute__((ext_vector_type(4)));
constexpr int BM = 256, BK = 64, HALF = 128, HTB = HALF * BK * 2  , STAGE_BYTES = 8 * HTB, NXCD = 8, WGM = 8;

__host__ __device__ __forceinline__ int lds_byte(int r, int c) { const int st = (r >> 4) * 2 + (c >> 5), rr = r & 15, cc = c & 31, ob = rr * 64 + cc * 2; return st * 1024 + (ob ^ (((ob >> 9) & 1) << 5)); }
__host__ __device__ __forceinline__ void stage_rc(int b, int& R, int& C) { const int st = b / 1024, sb = b % 1024, swz = sb ^ (((sb >> 9) & 1) << 5); R = (st >> 1) * 16 + swz / 64; C = (st & 1) * 32 + (swz % 64) / 2; }
__host__ __device__ __forceinline__ int perm32(int rho) { const int n = rho >> 4, i = rho & 15; return 8 * (i >> 2) + 4 * n + (i & 3); }

struct Unit { int pm, pn; };
struct Gemm { const bf16_t* A; const bf16_t* Bt; int M, N, K; };

struct StaticOrder {
    int nM, nN, nwg, G, c;
    __host__ __device__ void init(int M, int N, int G_, int c_) { nM = M / BM; nN = N / BM; nwg = nM * nN; G = G_; c = c_; }
    __host__ __device__ bool next(int i, Unit& u) const {
        const long L = (long)i * G + c; if (L >= nwg) return false;
        int wgid = (int)L; { const int q = nwg / NXCD, r = nwg % NXCD, xcd = wgid % NXCD, off = wgid / NXCD; wgid = (xcd < r ? xcd * (q + 1) : r * (q + 1) + (xcd - r) * q) + off; }
        const int nig = WGM * nN, gid = wgid / nig, fm = gid * WGM, gsz = (nM - fm) < WGM ? (nM - fm) : WGM;
        u.pm = fm + ((wgid % nig) % gsz); u.pn = (wgid % nig) / gsz; return true;
    }
    __device__ __forceinline__ void a_ready(const Unit&) const {}
    __device__ __forceinline__ void done(const Unit&) const {}
};

__device__ __forceinline__ unsigned cvt_pk_bf16(float lo, float hi) { unsigned r; asm volatile("v_cvt_pk_bf16_f32 %0, %1, %2" : "=v"(r) : "v"(lo), "v"(hi)); return r; }
typedef float f32x2 __attribute__((ext_vector_type(2)));
__device__ __forceinline__ float rstd_of_row(const float* rowss, int row, int fq) {
    const f32x4 pv = *(const f32x4*)(rowss + (size_t)row * 16 + 4 * fq);
    float s = (pv[0] + pv[1]) + (pv[2] + pv[3]);
    s += __shfl_xor(s, 16); s += __shfl_xor(s, 32);
    return rsqrtf(s * (1.0f / 1024.0f) + 1e-6f);
}
struct EpiProj {
    static constexpr bool PERM = true, AFTER_DRAIN = false;
    bf16_t* O; const float* rowss; const PG8_LAS float* tab; int tab_row0;
    __device__ __forceinline__ void operator()(const f32x4 (&acc)[2][2][4][2], const Unit& u, int wr, int wc, int fr, int fq) const {
        const int row0 = u.pm * BM + wr * 64 + fr, col0 = u.pn * BM + wc * 32 + 8 * fq;
        const __amdgpu_buffer_rsrc_t rsrc = __builtin_amdgcn_make_buffer_rsrc(O, 0, 16384 * 3072 * 2, 0x00020000);
#pragma unroll
        for (int ai = 0; ai < 2; ++ai)
#pragma unroll
            for (int m = 0; m < 4; ++m) { const int row = row0 + ai * HALF + m * 16; const float rs = tab ? tab[row - tab_row0] : rstd_of_row(rowss, row, fq);
                const unsigned boff = ((unsigned)row * 3072u + (unsigned)col0) * 2u;
#pragma unroll
                for (int bj = 0; bj < 2; ++bj) { const f32x4 v0 = acc[ai][bj][m][0] * rs, v1 = acc[ai][bj][m][1] * rs;
                    u32x4 w; w.x = cvt_pk_bf16(v0[0], v0[1]); w.y = cvt_pk_bf16(v0[2], v0[3]); w.z = cvt_pk_bf16(v1[0], v1[1]); w.w = cvt_pk_bf16(v1[2], v1[3]);
                    __builtin_amdgcn_raw_buffer_store_b128(w, rsrc, boff + bj * HALF * 2, 0,   16); } }
    }
};
__device__ __forceinline__ float silu_mul(float g, float u) { return g * __builtin_amdgcn_rcpf(1.0f + __expf(-g)) * u; }
struct EpiSwiglu {
    static constexpr bool PERM = true, AFTER_DRAIN = false;
    bf16_t* O; const float* rowss; const PG8_LAS float* tab; int tab_row0;
    __device__ __forceinline__ void operator()(const f32x4 (&acc)[2][2][4][2], const Unit& u, int wr, int wc, int fr, int fq) const {
        const int row0 = u.pm * BM + wr * 64 + fr, col0 = u.pn * HALF + wc * 32 + 8 * fq;
        const __amdgpu_buffer_rsrc_t rsrc = __builtin_amdgcn_make_buffer_rsrc(O, 0, 16384 * 2816 * 2, 0x00020000);
#pragma unroll
        for (int ai = 0; ai < 2; ++ai)
#pragma unroll
            for (int m = 0; m < 4; ++m) { const int row = row0 + ai * HALF + m * 16; const float rs = tab ? tab[row - tab_row0] : rstd_of_row(rowss, row, fq);
                const f32x4 g0 = acc[ai][0][m][0] * rs, g1 = acc[ai][0][m][1] * rs, u0 = acc[ai][1][m][0] * rs, u1 = acc[ai][1][m][1] * rs;
                u32x4 w; w.x = cvt_pk_bf16(silu_mul(g0[0], u0[0]), silu_mul(g0[1], u0[1])); w.y = cvt_pk_bf16(silu_mul(g0[2], u0[2]), silu_mul(g0[3], u0[3]));
                w.z = cvt_pk_bf16(silu_mul(g1[0], u1[0]), silu_mul(g1[1], u1[1])); w.w = cvt_pk_bf16(silu_mul(g1[2], u1[2]), silu_mul(g1[3], u1[3]));
                __builtin_amdgcn_raw_buffer_store_b128(w, rsrc, ((unsigned)row * 2816u + (unsigned)col0) * 2u, 0,   16); }
    }
};
struct EpiResidB {
    static constexpr bool PERM = true, AFTER_DRAIN = false;
    const float* base32; float* out32; bf16_t* xb; float* rowss;
    __device__ __forceinline__ void emit(const f32x4& v0, const f32x4& v1, size_t o, float& ss) const {
        if (out32) {
            const __amdgpu_buffer_rsrc_t ors = __builtin_amdgcn_make_buffer_rsrc(out32, 0, 16384 * 1024 * 4, 0x00020000);
            __builtin_amdgcn_raw_buffer_store_b128(__builtin_bit_cast(u32x4, v0), ors, (unsigned)o * 4u, 0,   16);
            __builtin_amdgcn_raw_buffer_store_b128(__builtin_bit_cast(u32x4, v1), ors, (unsigned)o * 4u + 16u, 0,   16); }
        else { ss += ((v0[0] * v0[0] + v0[1] * v0[1]) + (v0[2] * v0[2] + v0[3] * v0[3])) + ((v1[0] * v1[0] + v1[1] * v1[1]) + (v1[2] * v1[2] + v1[3] * v1[3]));
            u32x4 w; w.x = cvt_pk_bf16(v0[0], v0[1]); w.y = cvt_pk_bf16(v0[2], v0[3]); w.z = cvt_pk_bf16(v1[0], v1[1]); w.w = cvt_pk_bf16(v1[2], v1[3]);
            *(u32x4*)(xb + o) = w; }
    }
    __device__ __forceinline__ void operator()(const f32x4 (&acc)[2][2][4][2], const Unit& u, int wr, int wc, int fr, int fq) const {
        const int row0 = u.pm * BM + wr * 64 + fr, col0 = u.pn * BM + wc * 32 + 8 * fq;
        if (base32) {
#pragma unroll
            for (int ai = 0; ai < 2; ++ai)
#pragma unroll
                for (int m = 0; m < 4; ++m) { const int row = row0 + ai * HALF + m * 16; const size_t off = (size_t)row * 1024 + col0; float ss = 0.f;
                    f32x4 b[2][2];
#pragma unroll
                    for (int bj = 0; bj < 2; ++bj) { b[bj][0] = *(const f32x4*)(base32 + off + bj * HALF); b[bj][1] = *(const f32x4*)(base32 + off + bj * HALF + 4); }
#pragma unroll
                    for (int bj = 0; bj < 2; ++bj) emit(b[bj][0] + acc[ai][bj][m][0], b[bj][1] + acc[ai][bj][m][1], off + bj * HALF, ss);
                    if (!out32) { ss += __shfl_xor(ss, 16); ss += __shfl_xor(ss, 32); if (fq == 0) rowss[(size_t)row * 16 + u.pn * 4 + wc] = ss; } }
        } else {
#pragma unroll
            for (int ai = 0; ai < 2; ++ai) {
                u32x4 rb[4][2];
#pragma unroll
                for (int m = 0; m < 4; ++m)
#pragma unroll
                    for (int bj = 0; bj < 2; ++bj) rb[m][bj] = *(const u32x4*)(xb + (size_t)(row0 + ai * HALF + m * 16) * 1024 + col0 + bj * HALF);
                asm volatile("" ::: "memory");
#pragma unroll
                for (int m = 0; m < 4; ++m) { const int row = row0 + ai * HALF + m * 16; const size_t off = (size_t)row * 1024 + col0; float ss = 0.f;
#pragma unroll
                    for (int bj = 0; bj < 2; ++bj) { const u32x4 r = rb[m][bj];
                        const f32x4 b0 = (f32x4){__uint_as_float(r.x << 16), __uint_as_float(r.x & 0xffff0000u), __uint_as_float(r.y << 16), __uint_as_float(r.y & 0xffff0000u)};
                        const f32x4 b1 = (f32x4){__uint_as_float(r.z << 16), __uint_as_float(r.z & 0xffff0000u), __uint_as_float(r.w << 16), __uint_as_float(r.w & 0xffff0000u)};
                        emit(b0 + acc[ai][bj][m][0], b1 + acc[ai][bj][m][1], off + bj * HALF, ss); }
                    if (!out32) { ss += __shfl_xor(ss, 16); ss += __shfl_xor(ss, 32); if (fq == 0) rowss[(size_t)row * 16 + u.pn * 4 + wc] = ss; } }
                asm volatile("" ::: "memory");
            }
        }
    }
};
template <class Epi, class Sched, bool ALIGN_EPI = false, bool SP2 = false>
__device__ __forceinline__ void gemm_phase(PG8_LAS unsigned char* lds, const Gemm g, const Sched& S, const Epi& E) {
    int tid_ = threadIdx.x; asm volatile("" : "+v"(tid_));
    const int tid = tid_, wid = __builtin_amdgcn_readfirstlane(tid >> 6), lane = tid & 63, wr = wid >> 2, wc = wid & 3, fr = lane & 15, fq = lane >> 4;
    const int K = g.K, nt = K / BK;
    unsigned voffA[2], voffB[2];
#pragma unroll
    for (int i = 0; i < 2; ++i) { int R, C; stage_rc(tid * 16 + i * 8192, R, C); const int Rb = Epi::PERM ? ((R & ~31) + perm32(R & 31)) : R;
        voffA[i] = (unsigned)(R * K + C) * 2u; voffB[i] = (unsigned)(Rb * K + C) * 2u; }
    const size_t kstep = (size_t)(BK * 2);
    const size_t hstep = (size_t)HALF * K * 2;
    const size_t tstep = 2 * hstep;
    const unsigned ldsw = (unsigned)wid * 1024u;
    const int aoff = lds_byte(wr * 64 + fr, fq * 8), boff = lds_byte(wc * 32 + fr, fq * 8);
#define PG8_SA(b, h) (((b) * 2 + (h)) * HTB)
#define PG8_SB(b, h) ((4 + (b) * 2 + (h)) * HTB)
#define PG8_STAGE(bufoff, gbase, voff) do { _Pragma("unroll") for (int _i = 0; _i < 2; ++_i) \
        __builtin_amdgcn_global_load_lds((const unsigned*)((const char*)(gbase) + (voff)[_i]), (PG8_LAS unsigned*)(lds + (bufoff) + ldsw + _i * 8192), 16, 0, 0); } while (0)
#define PG8_LDA(dst, b, h) do { _Pragma("unroll") for (int m = 0; m < 4; ++m) _Pragma("unroll") for (int k = 0; k < 2; ++k) dst[m][k] = *(const PG8_LAS bf16x8*)(lds + PG8_SA(b, h) + aoff + m * 2048 + k * 1024); } while (0)
#define PG8_LDB(dst, b, h) do { _Pragma("unroll") for (int n = 0; n < 2; ++n) _Pragma("unroll") for (int k = 0; k < 2; ++k) dst[n][k] = *(const PG8_LAS bf16x8*)(lds + PG8_SB(b, h) + boff + n * 2048 + k * 1024); } while (0)
#define PG8_MMA(ai, bj, At, Bt) do { __builtin_amdgcn_s_setprio(1); _Pragma("unroll") for (int m = 0; m < 4; ++m) _Pragma("unroll") for (int n = 0; n < 2; ++n) _Pragma("unroll") for (int k = 0; k < 2; ++k) \
        acc[ai][bj][m][n] = __builtin_amdgcn_mfma_f32_16x16x32_bf16(Bt[n][k], At[m][k], acc[ai][bj][m][n], 0, 0, 0); __builtin_amdgcn_s_setprio(0); } while (0)
#define PG8_WAIT_V(n) asm volatile("s_waitcnt vmcnt(" #n ")" ::: "memory")
#define PG8_WAIT_L(n) asm volatile("s_waitcnt lgkmcnt(" #n ")" ::: "memory")
#define PG8_BAR __builtin_amdgcn_s_barrier()
#define PG8_SCHED __builtin_amdgcn_sched_barrier(0)
    Unit cur, nxt; int ui = 0;
    if (!S.next(0, cur)) return;
    f32x4 acc[2][2][4][2];
#pragma unroll
    for (int a = 0; a < 2; ++a)
#pragma unroll
        for (int b = 0; b < 2; ++b)
#pragma unroll
            for (int m = 0; m < 4; ++m)
#pragma unroll
                for (int n = 0; n < 2; ++n) acc[a][b][m][n] = (f32x4){0.f, 0.f, 0.f, 0.f};
    bf16x8 At[4][2], B0[2][2], B1[2][2];
    const char* cA = (const char*)g.A + (size_t)cur.pm * tstep; const char* cB = (const char*)g.Bt + (size_t)cur.pn * tstep;
    S.a_ready(cur);
    if constexpr (SP2) {
        PG8_STAGE(PG8_SB(0, 0), cB, voffB); PG8_STAGE(PG8_SB(0, 1), cB + hstep, voffB); PG8_STAGE(PG8_SA(0, 0), cA, voffA); PG8_STAGE(PG8_SA(0, 1), cA + hstep, voffA);
        if (wr == 1) PG8_BAR;
        PG8_WAIT_V(2); PG8_BAR;
        PG8_STAGE(PG8_SB(1, 0), cB + kstep, voffB); PG8_STAGE(PG8_SA(1, 0), cA + kstep, voffA); PG8_STAGE(PG8_SB(1, 1), cB + hstep + kstep, voffB);
        PG8_WAIT_V(6); PG8_BAR;
    } else {
        PG8_STAGE(PG8_SB(0, 0), cB, voffB); PG8_STAGE(PG8_SA(0, 0), cA, voffA); PG8_STAGE(PG8_SB(0, 1), cB + hstep, voffB); PG8_STAGE(PG8_SA(0, 1), cA + hstep, voffA);
        if (wr == 1) PG8_BAR;
        PG8_WAIT_V(4); PG8_BAR;
        PG8_STAGE(PG8_SB(1, 0), cB + kstep, voffB); PG8_STAGE(PG8_SA(1, 0), cA + kstep, voffA); PG8_STAGE(PG8_SB(1, 1), cB + hstep + kstep, voffB);
        PG8_WAIT_V(6); PG8_BAR;
    }
    for (;;) {
        const bool has_next = S.next(ui + 1, nxt);
        const char* nA = has_next ? (const char*)g.A + (size_t)nxt.pm * tstep : cA; const char* nB = has_next ? (const char*)g.Bt + (size_t)nxt.pn * tstep : cB;
        for (int t = 0; t < nt; t += 2) {
            const bool last = (t == nt - 2);
            const char* a1 = cA + (size_t)(t + 1) * kstep;
            const char* a2 = last ? nA : cA + (size_t)(t + 2) * kstep; const char* b2 = last ? nB : cB + (size_t)(t + 2) * kstep;
            const char* a3 = a2 + kstep; const char* b3 = b2 + kstep;
            if (last && has_next) S.a_ready(nxt);
            if constexpr (SP2) {
            PG8_LDB(B0, 0, 0); PG8_LDB(B1, 0, 1); PG8_SCHED; PG8_LDA(At, 0, 0); PG8_STAGE(PG8_SA(1, 1), a1 + hstep, voffA);
            PG8_WAIT_V(8); PG8_WAIT_L(0); PG8_BAR; PG8_MMA(0, 0, At, B0); PG8_MMA(0, 1, At, B1); PG8_BAR; PG8_SCHED;
            PG8_LDA(At, 0, 1); PG8_STAGE(PG8_SB(0, 0), b2, voffB); PG8_STAGE(PG8_SB(0, 1), b2 + hstep, voffB); PG8_STAGE(PG8_SA(0, 0), a2, voffA);
            PG8_WAIT_V(8); PG8_WAIT_L(0); PG8_BAR; PG8_MMA(1, 0, At, B0); PG8_MMA(1, 1, At, B1); PG8_BAR; PG8_SCHED;
            PG8_LDB(B0, 1, 0); PG8_LDB(B1, 1, 1); PG8_SCHED; PG8_LDA(At, 1, 0); PG8_STAGE(PG8_SA(0, 1), a2 + hstep, voffA);
            PG8_WAIT_V(8); PG8_WAIT_L(0); PG8_BAR; PG8_MMA(0, 0, At, B0); PG8_MMA(0, 1, At, B1); PG8_BAR; PG8_SCHED;
            PG8_LDA(At, 1, 1); PG8_STAGE(PG8_SB(1, 0), b3, voffB); PG8_STAGE(PG8_SB(1, 1), b3 + hstep, voffB); PG8_STAGE(PG8_SA(1, 0), a3, voffA);
            PG8_WAIT_V(8); PG8_WAIT_L(0); PG8_BAR; PG8_MMA(1, 0, At, B0); PG8_MMA(1, 1, At, B1); PG8_BAR; PG8_SCHED;
            } else {
            PG8_LDB(B0, 0, 0); PG8_SCHED; PG8_LDA(At, 0, 0); PG8_STAGE(PG8_SA(1, 1), a1 + hstep, voffA);
            PG8_WAIT_L(8); PG8_BAR; PG8_WAIT_L(0); PG8_MMA(0, 0, At, B0); PG8_BAR; PG8_SCHED;
            PG8_LDB(B1, 0, 1); PG8_STAGE(PG8_SB(0, 0), b2, voffB);
            PG8_BAR; PG8_WAIT_L(0); PG8_MMA(0, 1, At, B1); PG8_BAR;
            PG8_LDA(At, 0, 1); PG8_STAGE(PG8_SA(0, 0), a2, voffA);
            PG8_BAR; PG8_WAIT_L(0); PG8_MMA(1, 0, At, B0); PG8_BAR; PG8_SCHED;
            PG8_STAGE(PG8_SB(0, 1), b2 + hstep, voffB);
            PG8_WAIT_V(6); PG8_BAR; PG8_MMA(1, 1, At, B1); PG8_BAR;
            PG8_LDB(B0, 1, 0); PG8_SCHED; PG8_LDA(At, 1, 0); PG8_STAGE(PG8_SA(0, 1), a2 + hstep, voffA);
            PG8_WAIT_L(8); PG8_BAR; PG8_WAIT_L(0); PG8_MMA(0, 0, At, B0); PG8_BAR; PG8_SCHED;
            PG8_LDB(B1, 1, 1); PG8_STAGE(PG8_SB(1, 0), b3, voffB);
            PG8_BAR; PG8_WAIT_L(0); PG8_MMA(0, 1, At, B1); PG8_BAR;
            PG8_LDA(At, 1, 1); PG8_STAGE(PG8_SA(1, 0), a3, voffA);
            PG8_BAR; PG8_WAIT_L(0); PG8_MMA(1, 0, At, B0); PG8_BAR; PG8_SCHED;
            PG8_STAGE(PG8_SB(1, 1), b3 + hstep, voffB);
            PG8_WAIT_V(6); PG8_BAR; PG8_MMA(1, 1, At, B1); PG8_BAR;
            }
        }
        if constexpr (ALIGN_EPI) { if (wr == 0) PG8_BAR; }
        if constexpr (!Epi::AFTER_DRAIN) { E(acc, cur, wr, wc, fr, fq); S.done(cur); }
        if (!has_next) break;
#pragma unroll
        for (int a = 0; a < 2; ++a)
#pragma unroll
            for (int b = 0; b < 2; ++b)
#pragma unroll
                for (int m = 0; m < 4; ++m)
#pragma unroll
                    for (int n = 0; n < 2; ++n) acc[a][b][m][n] = (f32x4){0.f, 0.f, 0.f, 0.f};
        cur = nxt; cA = nA; cB = nB; ++ui;
        if constexpr (ALIGN_EPI) { if (wr == 1) PG8_BAR; }
    }
    PG8_WAIT_V(0);
    if constexpr (!ALIGN_EPI) { if (wr == 0) PG8_BAR; }
    PG8_BAR;
    if constexpr (Epi::AFTER_DRAIN) { E.fused(acc, cur, wr, wc, fr, fq, lds, wid, lane); S.done(cur); }
#undef PG8_SA
#undef PG8_SB
#undef PG8_STAGE
#undef PG8_LDA
#undef PG8_LDB
#undef PG8_MMA
#undef PG8_WAIT_V
#undef PG8_WAIT_L
#undef PG8_BAR
#undef PG8_SCHED
}
}

typedef __bf16 bf16x2_t __attribute__((ext_vector_type(2)));
typedef float f32x2_t __attribute__((ext_vector_type(2)));
__device__ __forceinline__ unsigned pk_bf16(float lo, float hi) { f32x2_t v = {lo, hi}; bf16x2_t b = __builtin_convertvector(v, bf16x2_t); return __builtin_bit_cast(unsigned, b); }
__device__ __forceinline__ bf16x8 pack8(float a, float b, float c, float d, float e, float f, float g, float h) {
    u32x4 w; w.x = pk_bf16(a, b); w.y = pk_bf16(c, d); w.z = pk_bf16(e, f); w.w = pk_bf16(g, h); return __builtin_bit_cast(bf16x8, w);
}
__device__ __forceinline__ float bflo(unsigned u) { return __uint_as_float(u << 16); }
__device__ __forceinline__ float bfhi(unsigned u) { return __uint_as_float(u & 0xffff0000u); }
#define LAS3 __attribute__((address_space(3)))
constexpr int MX_KB0 = 0, MX_KB1 = 9216, MX_KB2 = 18432, MX_KB3 = 27648, MX_VT0 = 36864, MX_VT1 = 46080, MX_VT2 = 55296, MX_VT3 = 64512, MX_BIAS = 73728, MX_FLAGS = 75264, MX_GAIN = 75392, MX_ROW = 144;
constexpr float LOG2E = 1.4426950408889634f;

struct TileRegs { u32x4 k, v; };
__device__ __forceinline__ TileRegs tile_load(const bf16_t* proj, int tok0, int kcol, int vcol, int tid) {
    TileRegs t;
    t.k = *(const u32x4*)(proj + (size_t)(tok0 + (tid >> 3)) * DIN + kcol + (tid & 7) * 8);
    t.v = *(const u32x4*)(proj + (size_t)(tok0 + (tid & 63)) * DIN + vcol + (tid >> 6) * 8);
    return t;
}
template <bool KNORM> __device__ __forceinline__ void tile_store(const TileRegs& t, LAS3 unsigned char* Kb, LAS3 unsigned char* Vt, f32x4 gk0, f32x4 gk1, int tid) {
    u32x4 kk = t.k;
    if (KNORM) {
        float f0 = bflo(kk.x), f1 = bfhi(kk.x), f2 = bflo(kk.y), f3 = bfhi(kk.y), f4 = bflo(kk.z), f5 = bfhi(kk.z), f6 = bflo(kk.w), f7 = bfhi(kk.w);
        float ss = ((f0 * f0 + f1 * f1) + (f2 * f2 + f3 * f3)) + ((f4 * f4 + f5 * f5) + (f6 * f6 + f7 * f7));
        ss += __shfl_xor(ss, 1); ss += __shfl_xor(ss, 2); ss += __shfl_xor(ss, 4);
        const float rs = rsqrtf(ss * (1.f / 64) + EPS);
        kk.x = pk_bf16(f0 * rs * gk0[0], f1 * rs * gk0[1]); kk.y = pk_bf16(f2 * rs * gk0[2], f3 * rs * gk0[3]);
        kk.z = pk_bf16(f4 * rs * gk1[0], f5 * rs * gk1[1]); kk.w = pk_bf16(f6 * rs * gk1[2], f7 * rs * gk1[3]);
    }
    *(LAS3 u32x4*)(Kb + (tid >> 3) * MX_ROW + (tid & 7) * 16) = kk;
    const int keyv = tid & 63, g4 = (keyv >> 2) & 3, pos = (keyv & ~15) | ((((g4 & 1) << 1) | (g4 >> 1)) << 2) | (keyv & 3);
    LAS3 unsigned char* vb = Vt + ((tid >> 6) * 8) * MX_ROW + pos * 2;
    *(LAS3 unsigned short*)(vb + 0 * MX_ROW) = (unsigned short)(t.v.x & 0xffffu); *(LAS3 unsigned short*)(vb + 1 * MX_ROW) = (unsigned short)(t.v.x >> 16);
    *(LAS3 unsigned short*)(vb + 2 * MX_ROW) = (unsigned short)(t.v.y & 0xffffu); *(LAS3 unsigned short*)(vb + 3 * MX_ROW) = (unsigned short)(t.v.y >> 16);
    *(LAS3 unsigned short*)(vb + 4 * MX_ROW) = (unsigned short)(t.v.z & 0xffffu); *(LAS3 unsigned short*)(vb + 5 * MX_ROW) = (unsigned short)(t.v.z >> 16);
    *(LAS3 unsigned short*)(vb + 6 * MX_ROW) = (unsigned short)(t.v.w & 0xffffu); *(LAS3 unsigned short*)(vb + 7 * MX_ROW) = (unsigned short)(t.v.w >> 16);
}
#define MFMA32(a, b, c) __builtin_amdgcn_mfma_f32_32x32x16_bf16((a), (b), (c), 0, 0, 0)
__device__ __forceinline__ f32x16 qk_block(const LAS3 unsigned char* Kb, int kb, const bf16x8 (&qf)[4], int r32, int hi, float init = 0.f) {
    f32x16 p;
#pragma unroll
    for (int i = 0; i < 16; ++i) p[i] = init;
    const LAS3 unsigned char* kp = Kb + (32 * kb + r32) * MX_ROW + 16 * hi;
#pragma unroll
    for (int d0 = 0; d0 < 4; ++d0) p = MFMA32(*(const LAS3 bf16x8*)(kp + 32 * d0), qf[d0], p);
    return p;
}
__device__ __forceinline__ void pv_block(const LAS3 unsigned char* Vt, int kb, const f32x16& w, f32x16& o0, f32x16& o1, int r32, int hi) {
    const bf16x8 pa0 = pack8(w[0], w[1], w[2], w[3], w[4], w[5], w[6], w[7]), pa1 = pack8(w[8], w[9], w[10], w[11], w[12], w[13], w[14], w[15]);
    const LAS3 unsigned char* vp = Vt + r32 * MX_ROW + (32 * kb + 8 * hi) * 2;
    o0 = MFMA32(*(const LAS3 bf16x8*)(vp), pa0, o0);
    o0 = MFMA32(*(const LAS3 bf16x8*)(vp + 32), pa1, o0);
    o1 = MFMA32(*(const LAS3 bf16x8*)(vp + 32 * MX_ROW), pa0, o1);
    o1 = MFMA32(*(const LAS3 bf16x8*)(vp + 32 * MX_ROW + 32), pa1, o1);
}
__device__ __forceinline__ void finish_head(const f32x16& o0, const f32x16& o1, float sc, bf16_t* yrow, const LAS3 float* gain, int hi) {
    float ss = 0.f;
#pragma unroll
    for (int i = 0; i < 16; ++i) ss += o0[i] * o0[i] + o1[i] * o1[i];
    ss += __shfl_xor(ss, 32);
    const float f = sc * rsqrtf(ss * sc * sc * (1.f / 64) + EPS);
#pragma unroll
    for (int db = 0; db < 2; ++db) {
        const f32x16& o = db ? o1 : o0;
#pragma unroll
        for (int pr_ = 0; pr_ < 2; ++pr_) {
            const int g = 2 * pr_;
            const f32x4 ga = *(const LAS3 f32x4*)(gain + 32 * db + 8 * g + 4 * hi), gb = *(const LAS3 f32x4*)(gain + 32 * db + 8 * (g + 1) + 4 * hi);
            const unsigned a0 = pk_bf16(o[4 * g] * f * ga[0], o[4 * g + 1] * f * ga[1]), b0 = pk_bf16(o[4 * g + 2] * f * ga[2], o[4 * g + 3] * f * ga[3]);
            const unsigned a1 = pk_bf16(o[4 * g + 4] * f * gb[0], o[4 * g + 5] * f * gb[1]), b1 = pk_bf16(o[4 * g + 6] * f * gb[2], o[4 * g + 7] * f * gb[3]);
            const auto sa = __builtin_amdgcn_permlane32_swap(a0, a1, false, false), sb = __builtin_amdgcn_permlane32_swap(b0, b1, false, false);
            u32x4 w; w.x = sa[0]; w.y = sb[0]; w.z = sa[1]; w.w = sb[1];
            *(u32x4*)(yrow + 32 * db + 16 * pr_ + 8 * hi) = w;
        }
    }
}

__device__ __forceinline__ void mixB_tile(const LAS3 unsigned char* Kb, const LAS3 unsigned char* Vt, const LAS3 float* bias, const bf16x8 (&qf)[4], f32x16& o0, f32x16& o1,
                                          float& mrun, float& lrun, bool& started, int jt, int pq, int r32, int hi) {
    f32x16 p0 = qk_block(Kb, 0, qf, r32, hi, -mrun), p1 = qk_block(Kb, 1, qf, r32, hi, -mrun);
    if (jt > 5) { const LAS3 float* bp = bias + (512 - 64 * jt + pq - 4 * hi + 128);
#pragma unroll
        for (int r = 0; r < 16; ++r) { p0[r] += bp[-((r & 3) + 8 * (r >> 2))]; p1[r] += bp[-((r & 3) + 8 * (r >> 2)) - 32]; } }
    float tm = fmaxf(p0[0], p1[0]);
#pragma unroll
    for (int r = 1; r < 16; ++r) tm = fmaxf(tm, fmaxf(p0[r], p1[r]));
    tm = fmaxf(tm, __shfl_xor(tm, 32));
    if (!started || __any(tm > 8.0f)) {
        const float delta = started ? fmaxf(tm, 0.f) : tm;
        mrun += delta;
#pragma unroll
        for (int r = 0; r < 16; ++r) { p0[r] -= delta; p1[r] -= delta; }
        if (started) { const float alpha = __builtin_amdgcn_exp2f(-delta); lrun *= alpha;
#pragma unroll
            for (int r = 0; r < 16; ++r) { o0[r] *= alpha; o1[r] *= alpha; } }
        started = true;
    }
    f32x2_t rs2 = {0.f, 0.f};
#pragma unroll
    for (int r = 0; r < 16; r += 2) { p0[r] = __builtin_amdgcn_exp2f(p0[r]); p0[r + 1] = __builtin_amdgcn_exp2f(p0[r + 1]); p1[r] = __builtin_amdgcn_exp2f(p1[r]); p1[r + 1] = __builtin_amdgcn_exp2f(p1[r + 1]);
        rs2 += (f32x2_t){p0[r], p0[r + 1]}; rs2 += (f32x2_t){p1[r], p1[r + 1]}; }
    lrun += rs2[0] + rs2[1];
    pv_block(Vt, 0, p0, o0, o1, r32, hi);
    pv_block(Vt, 1, p1, o0, o1, r32, hi);
}
__device__ __forceinline__ void mixB_pair(const LAS3 unsigned char* Ka, const LAS3 unsigned char* Va, const LAS3 unsigned char* Kb2, const LAS3 unsigned char* Vb2, const LAS3 float* bias,
                                          const bf16x8 (&qf)[4], f32x16& o0, f32x16& o1, float& mrun, float& lrun, bool& started, int jta, int pq, int r32, int hi) {
    const float init = -mrun;
    f32x16 a0 = qk_block(Ka, 0, qf, r32, hi, init), a1 = qk_block(Ka, 1, qf, r32, hi, init);
    f32x16 b0 = qk_block(Kb2, 0, qf, r32, hi, init), b1 = qk_block(Kb2, 1, qf, r32, hi, init);
    if (jta > 5) { const LAS3 float* bp = bias + (512 - 64 * jta + pq - 4 * hi + 128);
#pragma unroll
        for (int r = 0; r < 16; ++r) { a0[r] += bp[-((r & 3) + 8 * (r >> 2))]; a1[r] += bp[-((r & 3) + 8 * (r >> 2)) - 32]; } }
    if (jta + 1 > 5) { const LAS3 float* bp = bias + (512 - 64 * (jta + 1) + pq - 4 * hi + 128);
#pragma unroll
        for (int r = 0; r < 16; ++r) { b0[r] += bp[-((r & 3) + 8 * (r >> 2))]; b1[r] += bp[-((r & 3) + 8 * (r >> 2)) - 32]; } }
    float tm = fmaxf(fmaxf(a0[0], a1[0]), fmaxf(b0[0], b1[0]));
#pragma unroll
    for (int r = 1; r < 16; ++r) tm = fmaxf(tm, fmaxf(fmaxf(a0[r], a1[r]), fmaxf(b0[r], b1[r])));
    tm = fmaxf(tm, __shfl_xor(tm, 32));
    if (!started || __any(tm > 8.0f)) {
        const float delta = started ? fmaxf(tm, 0.f) : tm;
        mrun += delta;
#pragma unroll
        for (int r = 0; r < 16; ++r) { a0[r] -= delta; a1[r] -= delta; b0[r] -= delta; b1[r] -= delta; }
        if (started) { const float alpha = __builtin_amdgcn_exp2f(-delta); lrun *= alpha;
#pragma unroll
            for (int r = 0; r < 16; ++r) { o0[r] *= alpha; o1[r] *= alpha; } }
        started = true;
    }
    f32x2_t rs2 = {0.f, 0.f};
#pragma unroll
    for (int r = 0; r < 16; r += 2) { a0[r] = __builtin_amdgcn_exp2f(a0[r]); a0[r + 1] = __builtin_amdgcn_exp2f(a0[r + 1]); a1[r] = __builtin_amdgcn_exp2f(a1[r]); a1[r + 1] = __builtin_amdgcn_exp2f(a1[r + 1]);
        rs2 += (f32x2_t){a0[r], a0[r + 1]}; rs2 += (f32x2_t){a1[r], a1[r + 1]}; }
    pv_block(Va, 0, a0, o0, o1, r32, hi);
    pv_block(Va, 1, a1, o0, o1, r32, hi);
#pragma unroll
    for (int r = 0; r < 16; r += 2) { b0[r] = __builtin_amdgcn_exp2f(b0[r]); b0[r + 1] = __builtin_amdgcn_exp2f(b0[r + 1]); b1[r] = __builtin_amdgcn_exp2f(b1[r]); b1[r + 1] = __builtin_amdgcn_exp2f(b1[r + 1]);
        rs2 += (f32x2_t){b0[r], b0[r + 1]}; rs2 += (f32x2_t){b1[r], b1[r + 1]}; }
    lrun += rs2[0] + rs2[1];
    pv_block(Vb2, 0, b0, o0, o1, r32, hi);
    pv_block(Vb2, 1, b1, o0, o1, r32, hi);
}
__device__ __forceinline__ void mixB_mfma(const P& p, int l, int item, LAS3 unsigned char* lds, int tid_in) {
    int tid = tid_in; asm volatile("" : "+v"(tid));
    const int lane = tid & 63, wave = tid >> 6, r32 = lane & 31, hi = lane >> 5;
    const int h = item >> 6, C0 = (item & 63) * 4, myc = C0 + (wave >> 1), pq = (wave & 1) * 32 + r32, tokq = myc * 64 + pq;
    const bf16_t* pr = p.proj;
    const int kcol = 1280 + h * 64, vcol = 1792 + h * 64;
    const int T0 = C0 - 8 < 0 ? 0 : C0 - 8, T1 = C0 + 3;
    TileRegs tr0 = tile_load(pr, T0 * 64, kcol, vcol, tid), tr1 = tile_load(pr, (T0 + 1) * 64, kcol, vcol, tid),
             tr2 = tile_load(pr, (T0 + 2) * 64, kcol, vcol, tid), tr3 = tile_load(pr, (T0 + 3) * 64, kcol, vcol, tid);
    LAS3 float* bias = (LAS3 float*)(lds + MX_BIAS);
    LAS3 float* gainl = (LAS3 float*)(lds + MX_GAIN);
    if (tid < 64) gainl[tid] = p.out_norm_w[l * DM + 256 + h * 64 + tid];
    { const float* rb = p.rel_bias + (size_t)(l * 8 + h) * 257; const float far = rb[256];
      for (int i = tid; i < 328; i += 512) bias[i] = i < 256 ? (rb[i] - far) * LOG2E : 0.f; }
    const f32x4 gk0 = *(const f32x4*)(p.k_norm_w + l * 64 + (tid & 7) * 8), gk1 = *(const f32x4*)(p.k_norm_w + l * 64 + (tid & 7) * 8 + 4);
    bf16x8 qf[4];
    {
        u32x4 qr[4]; float ss = 0.f;
#pragma unroll
        for (int d0 = 0; d0 < 4; ++d0) { qr[d0] = *(const u32x4*)(pr + (size_t)tokq * DIN + 768 + h * 64 + 16 * d0 + 8 * hi);
            const float a0 = bflo(qr[d0].x), a1 = bfhi(qr[d0].x), a2 = bflo(qr[d0].y), a3 = bfhi(qr[d0].y), a4 = bflo(qr[d0].z), a5 = bfhi(qr[d0].z), a6 = bflo(qr[d0].w), a7 = bfhi(qr[d0].w);
            ss += ((a0 * a0 + a1 * a1) + (a2 * a2 + a3 * a3)) + ((a4 * a4 + a5 * a5) + (a6 * a6 + a7 * a7)); }
        ss += __shfl_xor(ss, 32);
        const float rs = rsqrtf(ss * (1.f / 64) + EPS) * (0.125f * LOG2E);
#pragma unroll
        for (int d0 = 0; d0 < 4; ++d0) { const float* gq = p.q_norm_w + l * 64 + 16 * d0 + 8 * hi; const f32x4 ga = *(const f32x4*)gq, gb = *(const f32x4*)(gq + 4);
            qf[d0] = pack8(bflo(qr[d0].x) * rs * ga[0], bfhi(qr[d0].x) * rs * ga[1], bflo(qr[d0].y) * rs * ga[2], bfhi(qr[d0].y) * rs * ga[3],
                           bflo(qr[d0].z) * rs * gb[0], bfhi(qr[d0].z) * rs * gb[1], bflo(qr[d0].w) * rs * gb[2], bfhi(qr[d0].w) * rs * gb[3]); }
    }
    f32x16 o0, o1;
#pragma unroll
    for (int i = 0; i < 16; ++i) { o0[i] = 0.f; o1[i] = 0.f; }
    float mrun = 0.f, lrun = 0.f; bool started = false;
#define MB_PAIR(TRA, TRB, KA, VA, KB_, VB_, TT) { LAS3 unsigned char* Ka = lds + (KA); LAS3 unsigned char* Va = lds + (VA); LAS3 unsigned char* Kb2 = lds + (KB_); LAS3 unsigned char* Vb2 = lds + (VB_); \
        tile_store<true>(TRA, Ka, Va, gk0, gk1, tid); tile_store<true>(TRB, Kb2, Vb2, gk0, gk1, tid); __syncthreads(); \
        if ((TT) + 4 <= T1) { TRA = tile_load(pr, ((TT) + 4) * 64, kcol, vcol, tid); TRB = tile_load(pr, ((TT) + 5) * 64, kcol, vcol, tid); } \
        const int jt = (TT) - (myc - 8); const bool aa = jt >= 0 && jt <= 8, ab = jt + 1 >= 0 && jt + 1 <= 8; \
        if (aa && ab) mixB_pair(Ka, Va, Kb2, Vb2, bias, qf, o0, o1, mrun, lrun, started, jt, pq, r32, hi); \
        else if (aa) mixB_tile(Ka, Va, bias, qf, o0, o1, mrun, lrun, started, jt, pq, r32, hi); \
        else if (ab) mixB_tile(Kb2, Vb2, bias, qf, o0, o1, mrun, lrun, started, jt + 1, pq, r32, hi); }
    for (int T = T0; T <= T1; T += 4) {
        MB_PAIR(tr0, tr1, MX_KB0, MX_VT0, MX_KB1, MX_VT1, T)
        MB_PAIR(tr2, tr3, MX_KB2, MX_VT2, MX_KB3, MX_VT3, T + 2)
    }
#undef MB_PAIR
    const float ltot = lrun + __shfl_xor(lrun, 32);
    finish_head(o0, o1, 1.0f / ltot, p.y + (size_t)tokq * DM + 256 + h * 64, gainl, hi);
    __syncthreads();
}

template <bool DIAG> __device__ __forceinline__ void mixA_block(const LAS3 unsigned char* Kb, const LAS3 unsigned char* Vt, int kb, const bf16x8 (&qf)[4], f32x16& o0, f32x16& o1, float& R,
                                                                int key0, int qabs, int r32, int hi) {
    const f32x16 z = qk_block(Kb, kb, qf, r32, hi);
    f32x16 E;
#pragma unroll
    for (int r = 0; r < 16; ++r) { const float az = __builtin_fabsf(z[r]);
        const float lg = __builtin_amdgcn_logf(1.0f + __builtin_amdgcn_exp2f(-az));
        float v = __builtin_fmaf(-0.5f, z[r] + az, -lg);
        if (DIAG) v = (key0 + crow(r, hi) < qabs) ? v : 0.f;
        E[r] = v; }
#pragma unroll
    for (int g = 0; g < 4; ++g) { E[4 * g + 2] += E[4 * g + 3]; E[4 * g + 1] += E[4 * g + 2]; E[4 * g] += E[4 * g + 1]; }
    float Gp[4];
#pragma unroll
    for (int g = 0; g < 4; ++g) Gp[g] = __shfl_xor(E[4 * g], 32);
    const float hm = hi == 0 ? 1.0f : 0.0f;
    float tail = R; f32x16 w;
#pragma unroll
    for (int g = 3; g >= 0; --g) {
        const float base = __builtin_fmaf(hm, Gp[g], tail);
#pragma unroll
        for (int i = 0; i < 4; ++i) { float x = __builtin_amdgcn_exp2f((z[4 * g + i] + E[4 * g + i]) + base);
            if (DIAG) x = (key0 + crow(4 * g + i, hi) < qabs) ? x : 0.f;
            w[4 * g + i] = x; }
        tail += E[4 * g] + Gp[g];
    }
    R = tail;
    pv_block(Vt, kb, w, o0, o1, r32, hi);
}
template <bool DIAG> __device__ __forceinline__ void sb_logrest(const f32x16& z, f32x16& E, int key0, int qabs, int hi) {
#pragma unroll
    for (int r = 0; r < 16; ++r) { const float az = __builtin_fabsf(z[r]);
        const float lg = __builtin_amdgcn_logf(1.0f + __builtin_amdgcn_exp2f(-az));
        float v = __builtin_fmaf(-0.5f, z[r] + az, -lg);
        if (DIAG) v = (key0 + crow(r, hi) < qabs) ? v : 0.f;
        E[r] = v; }
#pragma unroll
    for (int g = 0; g < 4; ++g) { E[4 * g + 2] += E[4 * g + 3]; E[4 * g + 1] += E[4 * g + 2]; E[4 * g] += E[4 * g + 1]; }
}
template <bool DIAG> __device__ __forceinline__ void sb_weights(const f32x16& z, const f32x16& E, const float (&Gp)[4], float Rin, f32x16& w, float hm, int key0, int qabs, int hi) {
    float tail = Rin;
#pragma unroll
    for (int g = 3; g >= 0; --g) {
        const float base = __builtin_fmaf(hm, Gp[g], tail);
#pragma unroll
        for (int i = 0; i < 4; ++i) { float x = __builtin_amdgcn_exp2f((z[4 * g + i] + E[4 * g + i]) + base);
            if (DIAG) x = (key0 + crow(4 * g + i, hi) < qabs) ? x : 0.f;
            w[4 * g + i] = x; }
        tail += E[4 * g] + Gp[g];
    }
}
template <bool D1> __device__ __forceinline__ void mixA_pair(const LAS3 unsigned char* Kb, const LAS3 unsigned char* Vt, const bf16x8 (&qf)[4], f32x16& o0, f32x16& o1, float& R,
                                                             int keyT, int qabs, int r32, int hi) {
    const f32x16 z1 = qk_block(Kb, 1, qf, r32, hi), z0 = qk_block(Kb, 0, qf, r32, hi);
    f32x16 E1, E0;
    sb_logrest<D1>(z1, E1, keyT + 32, qabs, hi);
    sb_logrest<false>(z0, E0, keyT, qabs, hi);
    float Gp1[4], Gp0[4];
#pragma unroll
    for (int g = 0; g < 4; ++g) { Gp1[g] = __shfl_xor(E1[4 * g], 32); Gp0[g] = __shfl_xor(E0[4 * g], 32); }
    float tot1 = 0.f, tot0 = 0.f;
#pragma unroll
    for (int g = 3; g >= 0; --g) { tot1 += E1[4 * g] + Gp1[g]; tot0 += E0[4 * g] + Gp0[g]; }
    const float hm = hi == 0 ? 1.0f : 0.0f, Rmid = R + tot1;
    f32x16 w1, w0;
    sb_weights<D1>(z1, E1, Gp1, R, w1, hm, keyT + 32, qabs, hi);
    sb_weights<false>(z0, E0, Gp0, Rmid, w0, hm, keyT, qabs, hi);
    R = Rmid + tot0;
    pv_block(Vt, 1, w1, o0, o1, r32, hi);
    pv_block(Vt, 0, w0, o0, o1, r32, hi);
}
__device__ __forceinline__ void mixA_tile(const LAS3 unsigned char* Kb, const LAS3 unsigned char* Vt, const bf16x8 (&qf)[4], f32x16& o0, f32x16& o1, float& R,
                                          int T, int q0w, int qabs, int r32, int hi) {
    const int keyT = 64 * T;
    if (keyT + 32 <= q0w + 30) {
        if (keyT + 63 >= q0w) mixA_pair<true>(Kb, Vt, qf, o0, o1, R, keyT, qabs, r32, hi);
        else mixA_pair<false>(Kb, Vt, qf, o0, o1, R, keyT, qabs, r32, hi);
    } else if (keyT <= q0w + 30) {
        if (keyT + 31 >= q0w) mixA_block<true>(Kb, Vt, 0, qf, o0, o1, R, keyT, qabs, r32, hi);
        else mixA_block<false>(Kb, Vt, 0, qf, o0, o1, R, keyT, qabs, r32, hi);
    }
}
constexpr float SB_THR2 = 87.0f;
__device__ __forceinline__ void mixA_mfma(const P& p, int l, int item, LAS3 unsigned char* lds, int tid_in) {
    int tid = tid_in; asm volatile("" : "+v"(tid));
    const int lane = tid & 63, wave = tid >> 6, r32 = lane & 31, hi = lane >> 5;
    const int h = item >> 6, Q0 = (item & 63) * 256, q0w = Q0 + 32 * wave, qabs = q0w + r32;
    const bf16_t* pr = p.proj;
    const int kcol = 256 + h * 64, vcol = 512 + h * 64;
    int T = Q0 / 64 + 3;
    TileRegs tr0 = tile_load(pr, T * 64, kcol, vcol, tid), tr1 = tile_load(pr, (T - 1) * 64, kcol, vcol, tid),
             tr2 = tile_load(pr, (T - 2) * 64, kcol, vcol, tid), tr3 = tile_load(pr, (T - 3) * 64, kcol, vcol, tid);
    LAS3 int* flags = (LAS3 int*)(lds + MX_FLAGS);
    LAS3 float* gainl = (LAS3 float*)(lds + MX_GAIN);
    if (tid < 64) gainl[tid] = p.out_norm_w[l * DM + h * 64 + tid];
    bf16x8 qf[4];
#pragma unroll
    for (int d0 = 0; d0 < 4; ++d0) { const u32x4 qr = *(const u32x4*)(pr + (size_t)qabs * DIN + h * 64 + 16 * d0 + 8 * hi); const float s = 0.125f * LOG2E;
        qf[d0] = pack8(bflo(qr.x) * s, bfhi(qr.x) * s, bflo(qr.y) * s, bfhi(qr.y) * s, bflo(qr.z) * s, bfhi(qr.z) * s, bflo(qr.w) * s, bfhi(qr.w) * s); }
    f32x16 o0, o1;
#pragma unroll
    for (int i = 0; i < 16; ++i) { o0[i] = 0.f; o1[i] = 0.f; }
    float R = 0.f; int done = 0;
    const f32x4 zero4 = {0.f, 0.f, 0.f, 0.f};
#define MA_STEP(TR, KOFF, VOFF, SLOT) { LAS3 unsigned char* Kb = lds + (KOFF); LAS3 unsigned char* Vt = lds + (VOFF); \
        tile_store<false>(TR, Kb, Vt, zero4, zero4, tid); if (lane == 0) flags[(SLOT) * 8 + wave] = done; __syncthreads(); \
        int alld = 1; _Pragma("unroll") for (int w = 0; w < 8; ++w) alld &= flags[(SLOT) * 8 + w]; \
        if (alld) break; \
        if (T >= 4) TR = tile_load(pr, (T - 4) * 64, kcol, vcol, tid); \
        if (!done) { mixA_tile(Kb, Vt, qf, o0, o1, R, T, q0w, qabs, r32, hi); done = __all(R < -SB_THR2) ? 1 : 0; } \
        --T; if (T < 0) break; }
    for (;;) {
        MA_STEP(tr0, MX_KB0, MX_VT0, 0) MA_STEP(tr1, MX_KB1, MX_VT1, 1) MA_STEP(tr2, MX_KB0, MX_VT0, 0) MA_STEP(tr3, MX_KB1, MX_VT1, 1)
    }
#undef MA_STEP
    finish_head(o0, o1, 1.0f, p.y + (size_t)qabs * DM + h * 64, gainl, hi);
    __syncthreads();
}

__device__ __forceinline__ void unpack8(const u32x4& u, float (&f)[8]) { f[0] = bflo(u.x); f[1] = bfhi(u.x); f[2] = bflo(u.y); f[3] = bfhi(u.y); f[4] = bflo(u.z); f[5] = bfhi(u.z); f[6] = bflo(u.w); f[7] = bfhi(u.w); }
__device__ __forceinline__ void mixC_vec4(const P& p, int l, int idx) {
    const int t0 = (idx >> 5) * 4, c = (idx & 31) * 8;
    const bf16_t* pr = p.proj; const float* cw = p.conv_w + l * 3 * 256;
    u32x4 gcr[6], xcr[6], gbr[4];
    const u32x4 z4 = {0u, 0u, 0u, 0u};
#pragma unroll
    for (int j = 0; j < 6; ++j) { const int tt = t0 - 2 + j;
        if (tt >= 0) { gcr[j] = *(const u32x4*)(pr + (size_t)tt * DIN + 2560 + c); xcr[j] = *(const u32x4*)(pr + (size_t)tt * DIN + 2816 + c); } else { gcr[j] = z4; xcr[j] = z4; } }
#pragma unroll
    for (int j = 0; j < 4; ++j) gbr[j] = *(const u32x4*)(pr + (size_t)(t0 + j) * DIN + 2304 + c);
    float w0[8], w1[8], w2[8], gn[8];
    { const f32x4 a = *(const f32x4*)(cw + c), b = *(const f32x4*)(cw + c + 4); w0[0] = a[0]; w0[1] = a[1]; w0[2] = a[2]; w0[3] = a[3]; w0[4] = b[0]; w0[5] = b[1]; w0[6] = b[2]; w0[7] = b[3]; }
    { const f32x4 a = *(const f32x4*)(cw + 256 + c), b = *(const f32x4*)(cw + 256 + c + 4); w1[0] = a[0]; w1[1] = a[1]; w1[2] = a[2]; w1[3] = a[3]; w1[4] = b[0]; w1[5] = b[1]; w1[6] = b[2]; w1[7] = b[3]; }
    { const f32x4 a = *(const f32x4*)(cw + 512 + c), b = *(const f32x4*)(cw + 512 + c + 4); w2[0] = a[0]; w2[1] = a[1]; w2[2] = a[2]; w2[3] = a[3]; w2[4] = b[0]; w2[5] = b[1]; w2[6] = b[2]; w2[7] = b[3]; }
    { const float* g = p.out_norm_w + l * DM + 768 + c; const f32x4 a = *(const f32x4*)g, b = *(const f32x4*)(g + 4); gn[0] = a[0]; gn[1] = a[1]; gn[2] = a[2]; gn[3] = a[3]; gn[4] = b[0]; gn[5] = b[1]; gn[6] = b[2]; gn[7] = b[3]; }
    float hc[6][8];
#pragma unroll
    for (int j = 0; j < 6; ++j) { float a[8], b[8]; unpack8(gcr[j], a); unpack8(xcr[j], b);
#pragma unroll
        for (int e = 0; e < 8; ++e) hc[j][e] = a[e] * b[e]; }
#pragma unroll
    for (int j = 0; j < 4; ++j) { float gb[8], y[8]; unpack8(gbr[j], gb); float ss = 0.f;
#pragma unroll
        for (int e = 0; e < 8; ++e) { float acc = w0[e] * hc[j][e]; acc += w1[e] * hc[j + 1][e]; acc += w2[e] * hc[j + 2][e]; y[e] = gb[e] * acc; ss += y[e] * y[e]; }
        ss += __shfl_xor(ss, 1); ss += __shfl_xor(ss, 2); ss += __shfl_xor(ss, 4);
        const float f = rsqrtf(ss * (1.f / 64) + EPS);
        u32x4 o; o.x = pk_bf16(y[0] * f * gn[0], y[1] * f * gn[1]); o.y = pk_bf16(y[2] * f * gn[2], y[3] * f * gn[3]);
        o.z = pk_bf16(y[4] * f * gn[4], y[5] * f * gn[5]); o.w = pk_bf16(y[6] * f * gn[6], y[7] * f * gn[7]);
        *(u32x4*)(p.y + (size_t)(t0 + j) * DM + 768 + c) = o; }
}

#define LAS __attribute__((address_space(3)))
#define XB_TMO      128
#define XB_XCNT(j)  (256  + 64 * (j))
#define XB_XSUB(j)  (1280 + 64 * (j))
#define XB_XGEN(j)  (2304 + 64 * (j))
#define XB_TOP      3328
#define XB_TOPGEN   3392
#define XCD_BAR_WORDS 3456
#define XB_SPIN_CAP (1u << 18)

__device__ __forceinline__ unsigned xb_ld(unsigned* p)              { return __hip_atomic_load(p, __ATOMIC_RELAXED, __HIP_MEMORY_SCOPE_AGENT); }
__device__ __forceinline__ unsigned xb_add(unsigned* p, unsigned v) { return __hip_atomic_fetch_add(p, v, __ATOMIC_RELAXED, __HIP_MEMORY_SCOPE_AGENT); }
__device__ __forceinline__ unsigned xb_xcc_id() { return (unsigned)__builtin_amdgcn_s_getreg((3 << 11) | 20) & 0xFu; }
#define XB_SPIN(cond, bar) do { unsigned _sp = 0; while (cond) { __builtin_amdgcn_s_sleep(1); \
    if ((++_sp & 255u) == 0u) { if (xb_ld(&(bar)[XB_TMO])) break; if (_sp > XB_SPIN_CAP) { atomicAdd(&(bar)[XB_TMO], 1u); break; } } } } while (0)

struct XcdBarrier {
    unsigned* bar; unsigned x;
    volatile LAS unsigned* st;
};

__device__ __forceinline__ XcdBarrier xcd_barrier_post(unsigned* bar, volatile LAS unsigned* st) {
    XcdBarrier b; b.bar = bar; b.x = xb_xcc_id(); b.st = st;
    if (threadIdx.x == 0) (void)xb_add(&bar[XB_XCNT(b.x)], 1u);
    return b;
}
__device__ __forceinline__ void xcd_barrier_complete(unsigned* bar, unsigned x, unsigned& nloc, unsigned& nx) {
    const unsigned G = gridDim.x * gridDim.y * gridDim.z;
    unsigned sum, cnt, mine, sp = 0u;
    for (;;) {
        sum = 0u; cnt = 0u; mine = 0u;
#pragma unroll
        for (unsigned j = 0; j < 16; ++j) { const unsigned c = xb_ld(&bar[XB_XCNT(j)]); sum += c; cnt += (c > 0u) ? 1u : 0u; mine = (j == x) ? c : mine; }
        if (sum == G) break;
        __builtin_amdgcn_s_sleep(1);
        if ((++sp & 255u) == 0u) { if (xb_ld(&bar[XB_TMO])) break; if (sp > XB_SPIN_CAP) { atomicAdd(&bar[XB_TMO], 1u); break; } }
    }
    nloc = mine > 0u ? mine : 1u; nx = cnt > 0u ? cnt : 1u;
}

__device__ __forceinline__ void xcd_barrier(const XcdBarrier& b) {
    asm volatile("s_waitcnt vmcnt(0)" ::: "memory");
    __syncthreads();
    if (threadIdx.x == 0) {
        unsigned* bar = b.bar;
        __builtin_amdgcn_s_waitcnt(0);
        unsigned nloc = b.st[0], nx = b.st[1];
        if (nloc == 0u) { xcd_barrier_complete(bar, b.x, nloc, nx); b.st[0] = nloc; b.st[1] = nx; }
        const unsigned old = xb_add(&bar[XB_XSUB(b.x)], 1u);
        const unsigned gen = old / nloc;
        if (old + 1u == (gen + 1u) * nloc) {
            __builtin_amdgcn_fence(__ATOMIC_RELEASE, "agent");
            asm volatile("s_waitcnt vmcnt(0)" ::: "memory");
            const unsigned og = xb_add(&bar[XB_TOP], 1u);
            const unsigned tg = og / nx;
            if (og + 1u == (tg + 1u) * nx) xb_add(&bar[XB_TOPGEN], 1u);
            else XB_SPIN(xb_ld(&bar[XB_TOPGEN]) == tg, bar);
            __builtin_amdgcn_fence(__ATOMIC_ACQUIRE, "agent");
            xb_add(&bar[XB_XGEN(b.x)], 1u);
            asm volatile("s_waitcnt vmcnt(0)" ::: "memory");
        } else {
            XB_SPIN(xb_ld(&bar[XB_XGEN(b.x)]) == gen, bar);
            __builtin_amdgcn_fence(__ATOMIC_ACQUIRE, "agent");
            asm volatile("s_waitcnt vmcnt(0)" ::: "memory");
        }
    }
    __syncthreads();
}

constexpr int LDS_BYTES = 147456;
__global__ void __launch_bounds__(512, 2) fwd(P p) {
    extern __shared__ __attribute__((aligned(16))) unsigned char lds[];
    cg::grid_group grid = cg::this_grid();
    const int tid = threadIdx.x, lane = tid & 63, wave = __builtin_amdgcn_readfirstlane(tid >> 6);
    const int G = gridDim.x, gw = blockIdx.x * 8 + wave, NGW = G * 8;
    LAS3 unsigned char* lds3 = (LAS3 unsigned char*)lds;
    if (tid < 64) ((LAS3 unsigned*)(lds3 + 131072))[tid] = 0u;
    __syncthreads();
    XcdBarrier bar = xcd_barrier_post(p.ctl, (volatile LAS3 unsigned*)(lds3 + 131072));
    for (int it = gw; it < T_LAYER; it += NGW) conv_item(p, it, (LAS3 float*)(lds3 + wave * 8448), lane);
    for (int row = gw; row < S; row += 4 * NGW) {
        f32x4 v[4][4]; float ssq[4];
#pragma unroll
        for (int q = 0; q < 4; ++q) { const int r = row + q * NGW < S ? row + q * NGW : row; const f32x4* xr = (const f32x4*)(p.x + (size_t)r * DM) + lane;
#pragma unroll
            for (int j = 0; j < 4; ++j) v[q][j] = xr[64 * j]; }
#pragma unroll
        for (int q = 0; q < 4; ++q) { float a = 0.f;
#pragma unroll
            for (int j = 0; j < 4; ++j) a += (v[q][j].x * v[q][j].x + v[q][j].y * v[q][j].y) + (v[q][j].z * v[q][j].z + v[q][j].w * v[q][j].w);
            ssq[q] = a; }
#pragma unroll
        for (int o = 1; o < 64; o <<= 1) {
#pragma unroll
            for (int q = 0; q < 4; ++q) ssq[q] += __shfl_xor(ssq[q], o); }
#pragma unroll
        for (int q = 0; q < 4; ++q) { const int r = row + q * NGW; if (r < S) {
            unsigned long long* o8 = (unsigned long long*)(p.xb + (size_t)r * DM) + lane;
#pragma unroll
            for (int j = 0; j < 4; ++j) o8[64 * j] = (unsigned long long)(f2bf(v[q][j].x) | (f2bf(v[q][j].y) << 16)) | ((unsigned long long)(f2bf(v[q][j].z) | (f2bf(v[q][j].w) << 16)) << 32);
            if (lane < 16) p.rowss[(size_t)r * 16 + lane] = lane == 0 ? ssq[q] : 0.f; } }
    }
    if (p.use_cg_sync) grid.sync();
    GSYNC();
    const bool use_tab = (G % 8 == 0);
    LAS3 float* rstd_tab = (LAS3 float*)(lds3 + 131072 + 2048);
    const int tab_row0 = 2048 * ((int)blockIdx.x % 8);
#define FILL_RSTD_TAB() do { if (use_tab) { int t_ = tid; asm volatile("" : "+v"(t_)); \
        for (int r = t_; r < 2048; r += 512) { const f32x4* q = (const f32x4*)(p.rowss + (size_t)(tab_row0 + r) * 16); const f32x4 a = q[0], b = q[1], c = q[2], d = q[3]; \
            const float sm = (((a[0] + a[1]) + (a[2] + a[3])) + ((b[0] + b[1]) + (b[2] + b[3]))) + (((c[0] + c[1]) + (c[2] + c[3])) + ((d[0] + d[1]) + (d[2] + d[3]))); \
            rstd_tab[r] = rsqrtf(sm * (1.0f / DM) + EPS); } \
        __syncthreads(); } } while (0)
    for (int l = 0; l < DEPTH; ++l) {
        {
            pg8::Gemm g{p.xb, p.wt_in + (size_t)l * DIN * DM, S, DIN, DM}; pg8::StaticOrder so; so.init(S, DIN, G, (int)blockIdx.x);
            FILL_RSTD_TAB();
            pg8::EpiProj E{p.proj, p.rowss, use_tab ? rstd_tab : nullptr, tab_row0};
            pg8::gemm_phase<pg8::EpiProj, pg8::StaticOrder, true, true>(lds3, g, so, E);
        }
        GSYNC();
        {
            if (G == 256) {
                const int x = (int)blockIdx.x % 8, j = (int)blockIdx.x / 8, pmx = 8 * x + (j >> 2), hh = j & 3;
                mixA_mfma(p, l, hh * 64 + pmx, lds3, tid);
                mixB_mfma(p, l, hh * 64 + pmx, lds3, tid);
                mixB_mfma(p, l, (hh + 4) * 64 + pmx, lds3, tid);
                { int tc = tid; asm volatile("" : "+v"(tc)); mixC_vec4(p, l, (512 * x + 16 * j) * 32 + tc); }
            } else {
            const int vcu = (G % 8 == 0) ? ((int)blockIdx.x % 8) * (G / 8) + (int)blockIdx.x / 8 : (int)blockIdx.x;
            for (int it = vcu; it < 256; it += G) mixA_mfma(p, l, it, lds3, tid);
            for (int it = vcu; it < 512; it += G) mixB_mfma(p, l, it, lds3, tid);
            { int tc = tid; asm volatile("" : "+v"(tc));
              for (int idx = (int)blockIdx.x * 512 + tc; idx < S * 8; idx += G * 512) mixC_vec4(p, l, idx); }
            }
        }
        GSYNC();
        {
            pg8::Gemm g{p.y, p.wt_out + (size_t)l * DM * DM, S, DM, DM}; pg8::StaticOrder so; so.init(S, DM, G, (int)blockIdx.x);
            pg8::EpiResidB E{l == 0 ? p.x : nullptr, nullptr, p.xb, p.rowss};
            pg8::gemm_phase<pg8::EpiResidB, pg8::StaticOrder, true, true>(lds3, g, so, E);
        }
        GSYNC();
        {
            pg8::Gemm g{p.xb, p.wt_gu + (size_t)l * 2 * DFF * DM, S, 2 * DFF, DM}; pg8::StaticOrder so; so.init(S, 2 * DFF, G, (int)blockIdx.x);
            FILL_RSTD_TAB();
            pg8::EpiSwiglu E{p.hid, p.rowss, use_tab ? rstd_tab : nullptr, tab_row0};
            pg8::gemm_phase<pg8::EpiSwiglu, pg8::StaticOrder, true, true>(lds3, g, so, E);
            if (l + 1 < DEPTH) {
                const int nwg = (S / 256) * (2 * DFF / 256), rem = nwg % G, first = rem == 0 ? 0 : rem, nidle = G - first;
                if ((int)blockIdx.x >= first) {
                    int wv = wave, ln = lane; asm volatile("" : "+s"(wv), "+v"(ln));
                    for (int it = ((int)blockIdx.x - first) * 8 + wv; it < T_LAYER; it += nidle * 8) conv_item(p, (l + 1) * T_LAYER + it, (LAS3 float*)(lds3 + wv * 8448), ln);
                }
            }
        }
        GSYNC();
        {
            pg8::Gemm g{p.hid, p.wt_dn + (size_t)l * DM * DFF, S, DM, DFF}; pg8::StaticOrder so; so.init(S, DM, G, (int)blockIdx.x);
            pg8::EpiResidB E{nullptr, l + 1 < DEPTH ? nullptr : p.out, p.xb, p.rowss};
            pg8::gemm_phase<pg8::EpiResidB, pg8::StaticOrder, true, true>(lds3, g, so, E);
        }
        if (l + 1 < DEPTH) GSYNC();
    }
}

extern "C" void kernel_launch(void* const* d_in, const int* in_sizes, int n_in, void* d_out, int out_size, void* d_ws, size_t ws_size, hipStream_t stream) {
    if (ws_size < WS_END) { fprintf(stderr, "ws too small: %zu < %zu\n", ws_size, (size_t)WS_END); return; }
    static int grid_blocks = 0;
    if (!grid_blocks) {
        int dev = 0, cus = 0, per_cu = 0;
        hipGetDevice(&dev);
        hipDeviceGetAttribute(&cus, hipDeviceAttributeMultiprocessorCount, dev);
        hipFuncSetAttribute((const void*)fwd, hipFuncAttributeMaxDynamicSharedMemorySize, LDS_BYTES);
        hipOccupancyMaxActiveBlocksPerMultiprocessor(&per_cu, (const void*)fwd, 512, LDS_BYTES);
        if (per_cu < 1) { fprintf(stderr, "occupancy query says %d blocks/CU\n", per_cu); per_cu = 1; }
        (void)hipGetLastError();
        grid_blocks = cus * per_cu;
    }
    P p{};
    p.x = (const float*)d_in[0]; p.attn_norm_w = (const float*)d_in[1]; p.w_in = (const float*)d_in[2]; p.q_norm_w = (const float*)d_in[3];
    p.k_norm_w = (const float*)d_in[4]; p.rel_bias = (const float*)d_in[5]; p.conv_w = (const float*)d_in[6]; p.out_norm_w = (const float*)d_in[7];
    p.w_out = (const float*)d_in[8]; p.ffn_norm_w = (const float*)d_in[9]; p.w_gate = (const float*)d_in[10]; p.w_up = (const float*)d_in[11];
    p.w_down = (const float*)d_in[12];
    p.out = (float*)d_out;
    char* ws = (char*)d_ws;
    p.wt_in = (bf16_t*)(ws + WS_WIN); p.wt_out = (bf16_t*)(ws + WS_WOUT); p.wt_gu = (bf16_t*)(ws + WS_WGU); p.wt_dn = (bf16_t*)(ws + WS_WDN);
    p.xb = (bf16_t*)(ws + WS_XB); p.y = (bf16_t*)(ws + WS_Y); p.rowss = (float*)(ws + WS_RSS); p.proj = (bf16_t*)(ws + WS_PROJ); p.hid = p.proj; p.ctl = (unsigned*)(ws + WS_CTL);
    if (hipMemsetAsync(ws + WS_CTL, 0, CTL_BYTES, stream) != hipSuccess) { fprintf(stderr, "memset failed\n"); return; }
    void* args[] = {&p};
    hipError_t e = hipLaunchCooperativeKernel((const void*)fwd, dim3(grid_blocks), dim3(512), args, LDS_BYTES, stream);
    if (e != hipSuccess) fprintf(stderr, "cooperative launch failed: %s (grid %d)\n", hipGetErrorString(e), grid_blocks);
}
```

```cpp
#include <hip/hip_runtime.h>
#include <hip/hip_cooperative_groups.h>
#include <stdint.h>
#include <cstdio>
namespace cg = cooperative_groups;
#define GSYNC() xcd_barrier(bar)

constexpr int S = 16384, DM = 1024, DIN = 3072, DFF = 2816, DEPTH = 4;
constexpr float EPS = 1e-6f;
typedef unsigned short bf16_t;
typedef short bf16x8 __attribute__((ext_vector_type(8)));
typedef float f32x16 __attribute__((ext_vector_type(16)));
typedef float f32x4 __attribute__((ext_vector_type(4)));
typedef unsigned u32x4 __attribute__((ext_vector_type(4)));

constexpr size_t WS_WIN = 0, WS_WOUT = 25165824, WS_WGU = 33554432, WS_WDN = 79691776, WS_XB = 102760448, WS_Y = 136314880,
                 WS_RSS = 169869312, WS_PROJ = 170917888, WS_CTL = 271581184, CTL_BYTES = 16384, WS_END = WS_CTL + CTL_BYTES;

struct P {
    const float *x, *attn_norm_w, *w_in, *q_norm_w, *k_norm_w, *rel_bias, *conv_w, *out_norm_w, *w_out, *ffn_norm_w, *w_gate, *w_up, *w_down;
    float* out;
    bf16_t *wt_in, *wt_out, *wt_gu, *wt_dn, *xb, *proj, *y, *hid;
    float* rowss;
    unsigned* ctl;
    int use_cg_sync, pad_;
};

__device__ __forceinline__ unsigned f2bf(float f) { unsigned u = __float_as_uint(f); return (u + 0x7fffu + ((u >> 16) & 1u)) >> 16; }
__device__ __forceinline__ float bf2f(bf16_t b) { return __uint_as_float(((unsigned)b) << 16); }
__device__ __forceinline__ float wave_sum(float v) {
#pragma unroll
    for (int o = 1; o < 64; o <<= 1) v += __shfl_xor(v, o);
    return v;
}
__device__ __forceinline__ float wave_max(float v) {
#pragma unroll
    for (int o = 1; o < 64; o <<= 1) v = fmaxf(v, __shfl_xor(v, o));
    return v;
}
__device__ __forceinline__ int crow(int r, int hi) { return (r & 3) + 8 * (r >> 2) + 4 * hi; }
#define WAVE_LDS_SYNC() asm volatile("s_waitcnt lgkmcnt(0)" ::: "memory")

__device__ __forceinline__ void conv_tile_wave(const float* __restrict__ W, int N, const float* gain, bf16_t* Wt, int K, int dst_row0, int k0, int n0,
                                               __attribute__((address_space(3))) float* tile, int lane) {
    const int lr = lane >> 3, lc = (lane & 7) * 4;
    f32x4 v[8];
#pragma unroll
    for (int i = 0; i < 8; ++i) v[i] = __builtin_nontemporal_load((const f32x4*)(W + (size_t)(k0 + 8 * i + lr) * N + n0 + lc));
    if (gain) {
#pragma unroll
        for (int i = 0; i < 8; ++i) v[i] = v[i] * gain[k0 + 8 * i + lr];
    }
#pragma unroll
    for (int i = 0; i < 8; ++i) { __attribute__((address_space(3))) float* t = tile + (8 * i + lr) * 33 + lc; t[0] = v[i][0]; t[1] = v[i][1]; t[2] = v[i][2]; t[3] = v[i][3]; }
    WAVE_LDS_SYNC();
    const int nr = lane >> 3, kc = lane & 7;
    const __amdgpu_buffer_rsrc_t wrs = __builtin_amdgcn_make_buffer_rsrc(Wt, 0, 16 * 1024 * 1024, 0x00020000);
#pragma unroll
    for (int it = 0; it < 4; ++it) { const int n = nr + 8 * it; const __attribute__((address_space(3))) float* sp = tile + (8 * kc) * 33 + n;
        u32x4 o; o.x = f2bf(sp[0]) | (f2bf(sp[33]) << 16); o.y = f2bf(sp[66]) | (f2bf(sp[99]) << 16); o.z = f2bf(sp[132]) | (f2bf(sp[165]) << 16); o.w = f2bf(sp[198]) | (f2bf(sp[231]) << 16);
        __builtin_amdgcn_raw_buffer_store_b128(o, wrs, ((unsigned)(dst_row0 + n) * (unsigned)K + (unsigned)(k0 + 8 * kc)) * 2u, 0,   16); }
    WAVE_LDS_SYNC();
}
constexpr int T_IN = 16 * 96, T_OUT = 16 * 32, T_G = 16 * 88, T_DN = 44 * 32, T_LAYER = T_IN + T_OUT + 2 * T_G + T_DN, T_ALL = DEPTH * T_LAYER;
__device__ __forceinline__ void conv_item(const P& p, int item, __attribute__((address_space(3))) float* tile, int lane) {
    int l = item / T_LAYER, r = item % T_LAYER;
    if (r < T_IN) { int kb = r / 96, nb = r % 96;
        conv_tile_wave(p.w_in + (size_t)l * DM * DIN, DIN, p.attn_norm_w + l * DM, p.wt_in + (size_t)l * DIN * DM, DM, nb * 32, kb * 64, nb * 32, tile, lane); return; }
    r -= T_IN;
    if (r < T_OUT) { int kb = r / 32, nb = r % 32;
        conv_tile_wave(p.w_out + (size_t)l * DM * DM, DM, nullptr, p.wt_out + (size_t)l * DM * DM, DM, nb * 32, kb * 64, nb * 32, tile, lane); return; }
    r -= T_OUT;
    if (r < 2 * T_G) { int up = r >= T_G; if (up) r -= T_G; int kb = r / 88, nb = r % 88; int n0 = nb * 32;
        int dst = 256 * (n0 / 128) + (n0 % 128) + (up ? 128 : 0);
        conv_tile_wave((up ? p.w_up : p.w_gate) + (size_t)l * DM * DFF, DFF, p.ffn_norm_w + l * DM, p.wt_gu + (size_t)l * 2 * DFF * DM, DM, dst, kb * 64, n0, tile, lane); return; }
    r -= 2 * T_G;
    { int kb = r / 32, nb = r % 32;
        conv_tile_wave(p.w_down + (size_t)l * DFF * DM, DM, nullptr, p.wt_dn + (size_t)l * DM * DFF, DFF, nb * 32, kb * 64, nb * 32, tile, lane); }
}

namespace pg8 {
#define PG8_LAS __attribute__((address_space(3)))
typedef unsigned short bf16_t;
typedef short bf16x8 __attribute__((ext_vector_type(8)));
typedef float f32x4 __attribute__((ext_vector_type(4)));
typedef unsigned u32x4 __attribute__((ext_vector_type(4)));
constexpr int BM = 256, BK = 64, HALF = 128, HTB = HALF * BK * 2  , STAGE_BYTES = 8 * HTB, NXCD = 8, WGM = 8;

__host__ __device__ __forceinline__ int lds_byte(int r, int c) { const int st = (r >> 4) * 2 + (c >> 5), rr = r & 15, cc = c & 31, ob = rr * 64 + cc * 2; return st * 1024 + (ob ^ (((ob >> 9) & 1) << 5)); }
__host__ __device__ __forceinline__ void stage_rc(int b, int& R, int& C) { const int st = b / 1024, sb = b % 1024, swz = sb ^ (((sb >> 9) & 1) << 5); R = (st >> 1) * 16 + swz / 64; C = (st & 1) * 32 + (swz % 64) / 2; }
__host__ __device__ __forceinline__ int perm32(int rho) { const int n = rho >> 4, i = rho & 15; return 8 * (i >> 2) + 4 * n + (i & 3); }

struct Unit { int pm, pn; };
struct Gemm { const bf16_t* A; const bf16_t* Bt; int M, N, K; };

struct StaticOrder {
    int nM, nN, nwg, G, c;
    __host__ __device__ void init(int M, int N, int G_, int c_) { nM = M / BM; nN = N / BM; nwg = nM * nN; G = G_; c = c_; }
    __host__ __device__ bool next(int i, Unit& u) const {
        const long L = (long)i * G + c; if (L >= nwg) return false;
        int wgid = (int)L; { const int q = nwg / NXCD, r = nwg % NXCD, xcd = wgid % NXCD, off = wgid / NXCD; wgid = (xcd < r ? xcd * (q + 1) : r * (q + 1) + (xcd - r) * q) + off; }
        const int nig = WGM * nN, gid = wgid / nig, fm = gid * WGM, gsz = (nM - fm) < WGM ? (nM - fm) : WGM;
        u.pm = fm + ((wgid % nig) % gsz); u.pn = (wgid % nig) / gsz; return true;
    }
    __device__ __forceinline__ void a_ready(const Unit&) const {}
    __device__ __forceinline__ void done(const Unit&) const {}
};

__device__ __forceinline__ unsigned cvt_pk_bf16(float lo, float hi) { unsigned r; asm volatile("v_cvt_pk_bf16_f32 %0, %1, %2" : "=v"(r) : "v"(lo), "v"(hi)); return r; }
typedef float f32x2 __attribute__((ext_vector_type(2)));
__device__ __forceinline__ float rstd_of_row(const float* rowss, int row, int fq) {
    const f32x4 pv = *(const f32x4*)(rowss + (size_t)row * 16 + 4 * fq);
    float s = (pv[0] + pv[1]) + (pv[2] + pv[3]);
    s += __shfl_xor(s, 16); s += __shfl_xor(s, 32);
    return rsqrtf(s * (1.0f / 1024.0f) + 1e-6f);
}
struct EpiProj {
    static constexpr bool PERM = true, AFTER_DRAIN = false;
    bf16_t* O; const float* rowss; const PG8_LAS float* tab; int tab_row0;
    __device__ __forceinline__ void operator()(const f32x4 (&acc)[2][2][4][2], const Unit& u, int wr, int wc, int fr, int fq) const {
        const int row0 = u.pm * BM + wr * 64 + fr, col0 = u.pn * BM + wc * 32 + 8 * fq;
        const __amdgpu_buffer_rsrc_t rsrc = __builtin_amdgcn_make_buffer_rsrc(O, 0, 16384 * 3072 * 2, 0x00020000);
#pragma unroll
        for (int ai = 0; ai < 2; ++ai)
#pragma unroll
            for (int m = 0; m < 4; ++m) { const int row = row0 + ai * HALF + m * 16; const float rs = tab ? tab[row - tab_row0] : rstd_of_row(rowss, row, fq);
                const unsigned boff = ((unsigned)row * 3072u + (unsigned)col0) * 2u;
#pragma unroll
                for (int bj = 0; bj < 2; ++bj) { const f32x4 v0 = acc[ai][bj][m][0] * rs, v1 = acc[ai][bj][m][1] * rs;
                    u32x4 w; w.x = cvt_pk_bf16(v0[0], v0[1]); w.y = cvt_pk_bf16(v0[2], v0[3]); w.z = cvt_pk_bf16(v1[0], v1[1]); w.w = cvt_pk_bf16(v1[2], v1[3]);
                    __builtin_amdgcn_raw_buffer_store_b128(w, rsrc, boff + bj * HALF * 2, 0,   16); } }
    }
};
__device__ __forceinline__ float silu_mul(float g, float u) { return g * __builtin_amdgcn_rcpf(1.0f + __expf(-g)) * u; }
struct EpiSwiglu {
    static constexpr bool PERM = true, AFTER_DRAIN = false;
    bf16_t* O; const float* rowss; const PG8_LAS float* tab; int tab_row0;
    __device__ __forceinline__ void operator()(const f32x4 (&acc)[2][2][4][2], const Unit& u, int wr, int wc, int fr, int fq) const {
        const int row0 = u.pm * BM + wr * 64 + fr, col0 = u.pn * HALF + wc * 32 + 8 * fq;
        const __amdgpu_buffer_rsrc_t rsrc = __builtin_amdgcn_make_buffer_rsrc(O, 0, 16384 * 2816 * 2, 0x00020000);
#pragma unroll
        for (int ai = 0; ai < 2; ++ai)
#pragma unroll
            for (int m = 0; m < 4; ++m) { const int row = row0 + ai * HALF + m * 16; const float rs = tab ? tab[row - tab_row0] : rstd_of_row(rowss, row, fq);
                const f32x4 g0 = acc[ai][0][m][0] * rs, g1 = acc[ai][0][m][1] * rs, u0 = acc[ai][1][m][0] * rs, u1 = acc[ai][1][m][1] * rs;
                u32x4 w; w.x = cvt_pk_bf16(silu_mul(g0[0], u0[0]), silu_mul(g0[1], u0[1])); w.y = cvt_pk_bf16(silu_mul(g0[2], u0[2]), silu_mul(g0[3], u0[3]));
                w.z = cvt_pk_bf16(silu_mul(g1[0], u1[0]), silu_mul(g1[1], u1[1])); w.w = cvt_pk_bf16(silu_mul(g1[2], u1[2]), silu_mul(g1[3], u1[3]));
                __builtin_amdgcn_raw_buffer_store_b128(w, rsrc, ((unsigned)row * 2816u + (unsigned)col0) * 2u, 0,   16); }
    }
};
struct EpiResidB {
    static constexpr bool PERM = true, AFTER_DRAIN = false;
    const float* base32; float* out32; bf16_t* xb; float* rowss;
    __device__ __forceinline__ void emit(const f32x4& v0, const f32x4& v1, size_t o, float& ss) const {
        if (out32) { *(f32x4*)(out32 + o) = v0; *(f32x4*)(out32 + o + 4) = v1; }
        else { ss += ((v0[0] * v0[0] + v0[1] * v0[1]) + (v0[2] * v0[2] + v0[3] * v0[3])) + ((v1[0] * v1[0] + v1[1] * v1[1]) + (v1[2] * v1[2] + v1[3] * v1[3]));
            u32x4 w; w.x = cvt_pk_bf16(v0[0], v0[1]); w.y = cvt_pk_bf16(v0[2], v0[3]); w.z = cvt_pk_bf16(v1[0], v1[1]); w.w = cvt_pk_bf16(v1[2], v1[3]);
            *(u32x4*)(xb + o) = w; }
    }
    __device__ __forceinline__ void operator()(const f32x4 (&acc)[2][2][4][2], const Unit& u, int wr, int wc, int fr, int fq) const {
        const int row0 = u.pm * BM + wr * 64 + fr, col0 = u.pn * BM + wc * 32 + 8 * fq;
        if (base32) {
#pragma unroll
            for (int ai = 0; ai < 2; ++ai)
#pragma unroll
                for (int m = 0; m < 4; ++m) { const int row = row0 + ai * HALF + m * 16; const size_t off = (size_t)row * 1024 + col0; float ss = 0.f;
                    f32x4 b[2][2];
#pragma unroll
                    for (int bj = 0; bj < 2; ++bj) { b[bj][0] = *(const f32x4*)(base32 + off + bj * HALF); b[bj][1] = *(const f32x4*)(base32 + off + bj * HALF + 4); }
#pragma unroll
                    for (int bj = 0; bj < 2; ++bj) emit(b[bj][0] + acc[ai][bj][m][0], b[bj][1] + acc[ai][bj][m][1], off + bj * HALF, ss);
                    if (!out32) { ss += __shfl_xor(ss, 16); ss += __shfl_xor(ss, 32); if (fq == 0) rowss[(size_t)row * 16 + u.pn * 4 + wc] = ss; } }
        } else {
#pragma unroll
            for (int ai = 0; ai < 2; ++ai) {
                u32x4 rb[4][2];
#pragma unroll
                for (int m = 0; m < 4; ++m)
#pragma unroll
                    for (int bj = 0; bj < 2; ++bj) rb[m][bj] = *(const u32x4*)(xb + (size_t)(row0 + ai * HALF + m * 16) * 1024 + col0 + bj * HALF);
                asm volatile("" ::: "memory");
#pragma unroll
                for (int m = 0; m < 4; ++m) { const int row = row0 + ai * HALF + m * 16; const size_t off = (size_t)row * 1024 + col0; float ss = 0.f;
#pragma unroll
                    for (int bj = 0; bj < 2; ++bj) { const u32x4 r = rb[m][bj];
                        const f32x4 b0 = (f32x4){__uint_as_float(r.x << 16), __uint_as_float(r.x & 0xffff0000u), __uint_as_float(r.y << 16), __uint_as_float(r.y & 0xffff0000u)};
                        const f32x4 b1 = (f32x4){__uint_as_float(r.z << 16), __uint_as_float(r.z & 0xffff0000u), __uint_as_float(r.w << 16), __uint_as_float(r.w & 0xffff0000u)};
                        emit(b0 + acc[ai][bj][m][0], b1 + acc[ai][bj][m][1], off + bj * HALF, ss); }
                    if (!out32) { ss += __shfl_xor(ss, 16); ss += __shfl_xor(ss, 32); if (fq == 0) rowss[(size_t)row * 16 + u.pn * 4 + wc] = ss; } }
                asm volatile("" ::: "memory");
            }
        }
    }
};
template <class Epi, class Sched, bool ALIGN_EPI = false, bool SP2 = false>
__device__ __forceinline__ void gemm_phase(PG8_LAS unsigned char* lds, const Gemm g, const Sched& S, const Epi& E) {
    int tid_ = threadIdx.x; asm volatile("" : "+v"(tid_));
    const int tid = tid_, wid = __builtin_amdgcn_readfirstlane(tid >> 6), lane = tid & 63, wr = wid >> 2, wc = wid & 3, fr = lane & 15, fq = lane >> 4;
    const int K = g.K, nt = K / BK;
    unsigned voffA[2], voffB[2];
#pragma unroll
    for (int i = 0; i < 2; ++i) { int R, C; stage_rc(tid * 16 + i * 8192, R, C); const int Rb = Epi::PERM ? ((R & ~31) + perm32(R & 31)) : R;
        voffA[i] = (unsigned)(R * K + C) * 2u; voffB[i] = (unsigned)(Rb * K + C) * 2u; }
    const size_t kstep = (size_t)(BK * 2);
    const size_t hstep = (size_t)HALF * K * 2;
    const size_t tstep = 2 * hstep;
    const unsigned ldsw = (unsigned)wid * 1024u;
    const int aoff = lds_byte(wr * 64 + fr, fq * 8), boff = lds_byte(wc * 32 + fr, fq * 8);
#define PG8_SA(b, h) (((b) * 2 + (h)) * HTB)
#define PG8_SB(b, h) ((4 + (b) * 2 + (h)) * HTB)
#define PG8_STAGE(bufoff, gbase, voff) do { _Pragma("unroll") for (int _i = 0; _i < 2; ++_i) \
        __builtin_amdgcn_global_load_lds((const unsigned*)((const char*)(gbase) + (voff)[_i]), (PG8_LAS unsigned*)(lds + (bufoff) + ldsw + _i * 8192), 16, 0, 0); } while (0)
#define PG8_LDA(dst, b, h) do { _Pragma("unroll") for (int m = 0; m < 4; ++m) _Pragma("unroll") for (int k = 0; k < 2; ++k) dst[m][k] = *(const PG8_LAS bf16x8*)(lds + PG8_SA(b, h) + aoff + m * 2048 + k * 1024); } while (0)
#define PG8_LDB(dst, b, h) do { _Pragma("unroll") for (int n = 0; n < 2; ++n) _Pragma("unroll") for (int k = 0; k < 2; ++k) dst[n][k] = *(const PG8_LAS bf16x8*)(lds + PG8_SB(b, h) + boff + n * 2048 + k * 1024); } while (0)
#define PG8_MMA(ai, bj, At, Bt) do { __builtin_amdgcn_s_setprio(1); _Pragma("unroll") for (int m = 0; m < 4; ++m) _Pragma("unroll") for (int n = 0; n < 2; ++n) _Pragma("unroll") for (int k = 0; k < 2; ++k) \
        acc[ai][bj][m][n] = __builtin_amdgcn_mfma_f32_16x16x32_bf16(Bt[n][k], At[m][k], acc[ai][bj][m][n], 0, 0, 0); __builtin_amdgcn_s_setprio(0); } while (0)
#define PG8_WAIT_V(n) asm volatile("s_waitcnt vmcnt(" #n ")" ::: "memory")
#define PG8_WAIT_L(n) asm volatile("s_waitcnt lgkmcnt(" #n ")" ::: "memory")
#define PG8_BAR __builtin_amdgcn_s_barrier()
#define PG8_SCHED __builtin_amdgcn_sched_barrier(0)
    Unit cur, nxt; int ui = 0;
    if (!S.next(0, cur)) return;
    f32x4 acc[2][2][4][2];
#pragma unroll
    for (int a = 0; a < 2; ++a)
#pragma unroll
        for (int b = 0; b < 2; ++b)
#pragma unroll
            for (int m = 0; m < 4; ++m)
#pragma unroll
                for (int n = 0; n < 2; ++n) acc[a][b][m][n] = (f32x4){0.f, 0.f, 0.f, 0.f};
    bf16x8 At[4][2], B0[2][2], B1[2][2];
    const char* cA = (const char*)g.A + (size_t)cur.pm * tstep; const char* cB = (const char*)g.Bt + (size_t)cur.pn * tstep;
    S.a_ready(cur);
    if constexpr (SP2) {
        PG8_STAGE(PG8_SB(0, 0), cB, voffB); PG8_STAGE(PG8_SB(0, 1), cB + hstep, voffB); PG8_STAGE(PG8_SA(0, 0), cA, voffA); PG8_STAGE(PG8_SA(0, 1), cA + hstep, voffA);
        if (wr == 1) PG8_BAR;
        PG8_WAIT_V(2); PG8_BAR;
        PG8_STAGE(PG8_SB(1, 0), cB + kstep, voffB); PG8_STAGE(PG8_SA(1, 0), cA + kstep, voffA); PG8_STAGE(PG8_SB(1, 1), cB + hstep + kstep, voffB);
        PG8_WAIT_V(6); PG8_BAR;
    } else {
        PG8_STAGE(PG8_SB(0, 0), cB, voffB); PG8_STAGE(PG8_SA(0, 0), cA, voffA); PG8_STAGE(PG8_SB(0, 1), cB + hstep, voffB); PG8_STAGE(PG8_SA(0, 1), cA + hstep, voffA);
        if (wr == 1) PG8_BAR;
        PG8_WAIT_V(4); PG8_BAR;
        PG8_STAGE(PG8_SB(1, 0), cB + kstep, voffB); PG8_STAGE(PG8_SA(1, 0), cA + kstep, voffA); PG8_STAGE(PG8_SB(1, 1), cB + hstep + kstep, voffB);
        PG8_WAIT_V(6); PG8_BAR;
    }
    for (;;) {
        const bool has_next = S.next(ui + 1, nxt);
        const char* nA = has_next ? (const char*)g.A + (size_t)nxt.pm * tstep : cA; const char* nB = has_next ? (const char*)g.Bt + (size_t)nxt.pn * tstep : cB;
        for (int t = 0; t < nt; t += 2) {
            const bool last = (t == nt - 2);
            const char* a1 = cA + (size_t)(t + 1) * kstep;
            const char* a2 = last ? nA : cA + (size_t)(t + 2) * kstep; const char* b2 = last ? nB : cB + (size_t)(t + 2) * kstep;
            const char* a3 = a2 + kstep; const char* b3 = b2 + kstep;
            if (last && has_next) S.a_ready(nxt);
            if constexpr (SP2) {
            PG8_LDB(B0, 0, 0); PG8_LDB(B1, 0, 1); PG8_SCHED; PG8_LDA(At, 0, 0); PG8_STAGE(PG8_SA(1, 1), a1 + hstep, voffA);
            PG8_WAIT_V(8); PG8_WAIT_L(0); PG8_BAR; PG8_MMA(0, 0, At, B0); PG8_MMA(0, 1, At, B1); PG8_BAR; PG8_SCHED;
            PG8_LDA(At, 0, 1); PG8_STAGE(PG8_SB(0, 0), b2, voffB); PG8_STAGE(PG8_SB(0, 1), b2 + hstep, voffB); PG8_STAGE(PG8_SA(0, 0), a2, voffA);
            PG8_WAIT_V(8); PG8_WAIT_L(0); PG8_BAR; PG8_MMA(1, 0, At, B0); PG8_MMA(1, 1, At, B1); PG8_BAR; PG8_SCHED;
            PG8_LDB(B0, 1, 0); PG8_LDB(B1, 1, 1); PG8_SCHED; PG8_LDA(At, 1, 0); PG8_STAGE(PG8_SA(0, 1), a2 + hstep, voffA);
            PG8_WAIT_V(8); PG8_WAIT_L(0); PG8_BAR; PG8_MMA(0, 0, At, B0); PG8_MMA(0, 1, At, B1); PG8_BAR; PG8_SCHED;
            PG8_LDA(At, 1, 1); PG8_STAGE(PG8_SB(1, 0), b3, voffB); PG8_STAGE(PG8_SB(1, 1), b3 + hstep, voffB); PG8_STAGE(PG8_SA(1, 0), a3, voffA);
            PG8_WAIT_V(8); PG8_WAIT_L(0); PG8_BAR; PG8_MMA(1, 0, At, B0); PG8_MMA(1, 1, At, B1); PG8_BAR; PG8_SCHED;
            } else {
            PG8_LDB(B0, 0, 0); PG8_SCHED; PG8_LDA(At, 0, 0); PG8_STAGE(PG8_SA(1, 1), a1 + hstep, voffA);
            PG8_WAIT_L(8); PG8_BAR; PG8_WAIT_L(0); PG8_MMA(0, 0, At, B0); PG8_BAR; PG8_SCHED;
            PG8_LDB(B1, 0, 1); PG8_STAGE(PG8_SB(0, 0), b2, voffB);
            PG8_BAR; PG8_WAIT_L(0); PG8_MMA(0, 1, At, B1); PG8_BAR;
            PG8_LDA(At, 0, 1); PG8_STAGE(PG8_SA(0, 0), a2, voffA);
            PG8_BAR; PG8_WAIT_L(0); PG8_MMA(1, 0, At, B0); PG8_BAR; PG8_SCHED;
            PG8_STAGE(PG8_SB(0, 1), b2 + hstep, voffB);
            PG8_WAIT_V(6); PG8_BAR; PG8_MMA(1, 1, At, B1); PG8_BAR;
            PG8_LDB(B0, 1, 0); PG8_SCHED; PG8_LDA(At, 1, 0); PG8_STAGE(PG8_SA(0, 1), a2 + hstep, voffA);
            PG8_WAIT_L(8); PG8_BAR; PG8_WAIT_L(0); PG8_MMA(0, 0, At, B0); PG8_BAR; PG8_SCHED;
            PG8_LDB(B1, 1, 1); PG8_STAGE(PG8_SB(1, 0), b3, voffB);
            PG8_BAR; PG8_WAIT_L(0); PG8_MMA(0, 1, At, B1); PG8_BAR;
            PG8_LDA(At, 1, 1); PG8_STAGE(PG8_SA(1, 0), a3, voffA);
            PG8_BAR; PG8_WAIT_L(0); PG8_MMA(1, 0, At, B0); PG8_BAR; PG8_SCHED;
            PG8_STAGE(PG8_SB(1, 1), b3 + hstep, voffB);
            PG8_WAIT_V(6); PG8_BAR; PG8_MMA(1, 1, At, B1); PG8_BAR;
            }
        }
        if constexpr (ALIGN_EPI) { if (wr == 0) PG8_BAR; }
        if constexpr (!Epi::AFTER_DRAIN) { E(acc, cur, wr, wc, fr, fq); S.done(cur); }
        if (!has_next) break;
#pragma unroll
        for (int a = 0; a < 2; ++a)
#pragma unroll
            for (int b = 0; b < 2; ++b)
#pragma unroll
                for (int m = 0; m < 4; ++m)
#pragma unroll
                    for (int n = 0; n < 2; ++n) acc[a][b][m][n] = (f32x4){0.f, 0.f, 0.f, 0.f};
        cur = nxt; cA = nA; cB = nB; ++ui;
        if constexpr (ALIGN_EPI) { if (wr == 1) PG8_BAR; }
    }
    PG8_WAIT_V(0);
    if constexpr (!ALIGN_EPI) { if (wr == 0) PG8_BAR; }
    PG8_BAR;
    if constexpr (Epi::AFTER_DRAIN) { E.fused(acc, cur, wr, wc, fr, fq, lds, wid, lane); S.done(cur); }
#undef PG8_SA
#undef PG8_SB
#undef PG8_STAGE
#undef PG8_LDA
#undef PG8_LDB
#undef PG8_MMA
#undef PG8_WAIT_V
#undef PG8_WAIT_L
#undef PG8_BAR
#undef PG8_SCHED
}
}

typedef __bf16 bf16x2_t __attribute__((ext_vector_type(2)));
typedef float f32x2_t __attribute__((ext_vector_type(2)));
__device__ __forceinline__ unsigned pk_bf16(float lo, float hi) { f32x2_t v = {lo, hi}; bf16x2_t b = __builtin_convertvector(v, bf16x2_t); return __builtin_bit_cast(unsigned, b); }
__device__ __forceinline__ bf16x8 pack8(float a, float b, float c, float d, float e, float f, float g, float h) {
    u32x4 w; w.x = pk_bf16(a, b); w.y = pk_bf16(c, d); w.z = pk_bf16(e, f); w.w = pk_bf16(g, h); return __builtin_bit_cast(bf16x8, w);
}
__device__ __forceinline__ float bflo(unsigned u) { return __uint_as_float(u << 16); }
__device__ __forceinline__ float bfhi(unsigned u) { return __uint_as_float(u & 0xffff0000u); }
#define LAS3 __attribute__((address_space(3)))
constexpr int MX_KB0 = 0, MX_KB1 = 9216, MX_KB2 = 18432, MX_KB3 = 27648, MX_VT0 = 36864, MX_VT1 = 46080, MX_VT2 = 55296, MX_VT3 = 64512, MX_BIAS = 73728, MX_FLAGS = 75264, MX_GAIN = 75392, MX_ROW = 144;
constexpr float LOG2E = 1.4426950408889634f;

struct TileRegs { u32x4 k, v; };
__device__ __forceinline__ TileRegs tile_load(const bf16_t* proj, int tok0, int kcol, int vcol, int tid) {
    TileRegs t;
    t.k = *(const u32x4*)(proj + (size_t)(tok0 + (tid >> 3)) * DIN + kcol + (tid & 7) * 8);
    t.v = *(const u32x4*)(proj + (size_t)(tok0 + (tid & 63)) * DIN + vcol + (tid >> 6) * 8);
    return t;
}
template <bool KNORM> __device__ __forceinline__ void tile_store(const TileRegs& t, LAS3 unsigned char* Kb, LAS3 unsigned char* Vt, f32x4 gk0, f32x4 gk1, int tid) {
    u32x4 kk = t.k;
    if (KNORM) {
        float f0 = bflo(kk.x), f1 = bfhi(kk.x), f2 = bflo(kk.y), f3 = bfhi(kk.y), f4 = bflo(kk.z), f5 = bfhi(kk.z), f6 = bflo(kk.w), f7 = bfhi(kk.w);
        float ss = ((f0 * f0 + f1 * f1) + (f2 * f2 + f3 * f3)) + ((f4 * f4 + f5 * f5) + (f6 * f6 + f7 * f7));
        ss += __shfl_xor(ss, 1); ss += __shfl_xor(ss, 2); ss += __shfl_xor(ss, 4);
        const float rs = rsqrtf(ss * (1.f / 64) + EPS);
        kk.x = pk_bf16(f0 * rs * gk0[0], f1 * rs * gk0[1]); kk.y = pk_bf16(f2 * rs * gk0[2], f3 * rs * gk0[3]);
        kk.z = pk_bf16(f4 * rs * gk1[0], f5 * rs * gk1[1]); kk.w = pk_bf16(f6 * rs * gk1[2], f7 * rs * gk1[3]);
    }
    *(LAS3 u32x4*)(Kb + (tid >> 3) * MX_ROW + (tid & 7) * 16) = kk;
    const int keyv = tid & 63, g4 = (keyv >> 2) & 3, pos = (keyv & ~15) | ((((g4 & 1) << 1) | (g4 >> 1)) << 2) | (keyv & 3);
    LAS3 unsigned char* vb = Vt + ((tid >> 6) * 8) * MX_ROW + pos * 2;
    *(LAS3 unsigned short*)(vb + 0 * MX_ROW) = (unsigned short)(t.v.x & 0xffffu); *(LAS3 unsigned short*)(vb + 1 * MX_ROW) = (unsigned short)(t.v.x >> 16);
    *(LAS3 unsigned short*)(vb + 2 * MX_ROW) = (unsigned short)(t.v.y & 0xffffu); *(LAS3 unsigned short*)(vb + 3 * MX_ROW) = (unsigned short)(t.v.y >> 16);
    *(LAS3 unsigned short*)(vb + 4 * MX_ROW) = (unsigned short)(t.v.z & 0xffffu); *(LAS3 unsigned short*)(vb + 5 * MX_ROW) = (unsigned short)(t.v.z >> 16);
    *(LAS3 unsigned short*)(vb + 6 * MX_ROW) = (unsigned short)(t.v.w & 0xffffu); *(LAS3 unsigned short*)(vb + 7 * MX_ROW) = (unsigned short)(t.v.w >> 16);
}
#define MFMA32(a, b, c) __builtin_amdgcn_mfma_f32_32x32x16_bf16((a), (b), (c), 0, 0, 0)
__device__ __forceinline__ f32x16 qk_block(const LAS3 unsigned char* Kb, int kb, const bf16x8 (&qf)[4], int r32, int hi, float init = 0.f) {
    f32x16 p;
#pragma unroll
    for (int i = 0; i < 16; ++i) p[i] = init;
    const LAS3 unsigned char* kp = Kb + (32 * kb + r32) * MX_ROW + 16 * hi;
#pragma unroll
    for (int d0 = 0; d0 < 4; ++d0) p = MFMA32(*(const LAS3 bf16x8*)(kp + 32 * d0), qf[d0], p);
    return p;
}
__device__ __forceinline__ void pv_block(const LAS3 unsigned char* Vt, int kb, const f32x16& w, f32x16& o0, f32x16& o1, int r32, int hi) {
    const bf16x8 pa0 = pack8(w[0], w[1], w[2], w[3], w[4], w[5], w[6], w[7]), pa1 = pack8(w[8], w[9], w[10], w[11], w[12], w[13], w[14], w[15]);
    const LAS3 unsigned char* vp = Vt + r32 * MX_ROW + (32 * kb + 8 * hi) * 2;
    o0 = MFMA32(*(const LAS3 bf16x8*)(vp), pa0, o0);
    o0 = MFMA32(*(const LAS3 bf16x8*)(vp + 32), pa1, o0);
    o1 = MFMA32(*(const LAS3 bf16x8*)(vp + 32 * MX_ROW), pa0, o1);
    o1 = MFMA32(*(const LAS3 bf16x8*)(vp + 32 * MX_ROW + 32), pa1, o1);
}
__device__ __forceinline__ void finish_head(const f32x16& o0, const f32x16& o1, float sc, bf16_t* yrow, const LAS3 float* gain, int hi) {
    float ss = 0.f;
#pragma unroll
    for (int i = 0; i < 16; ++i) ss += o0[i] * o0[i] + o1[i] * o1[i];
    ss += __shfl_xor(ss, 32);
    const float f = sc * rsqrtf(ss * sc * sc * (1.f / 64) + EPS);
#pragma unroll
    for (int db = 0; db < 2; ++db) {
        const f32x16& o = db ? o1 : o0;
#pragma unroll
        for (int pr_ = 0; pr_ < 2; ++pr_) {
            const int g = 2 * pr_;
            const f32x4 ga = *(const LAS3 f32x4*)(gain + 32 * db + 8 * g + 4 * hi), gb = *(const LAS3 f32x4*)(gain + 32 * db + 8 * (g + 1) + 4 * hi);
            const unsigned a0 = pk_bf16(o[4 * g] * f * ga[0], o[4 * g + 1] * f * ga[1]), b0 = pk_bf16(o[4 * g + 2] * f * ga[2], o[4 * g + 3] * f * ga[3]);
            const unsigned a1 = pk_bf16(o[4 * g + 4] * f * gb[0], o[4 * g + 5] * f * gb[1]), b1 = pk_bf16(o[4 * g + 6] * f * gb[2], o[4 * g + 7] * f * gb[3]);
            const auto sa = __builtin_amdgcn_permlane32_swap(a0, a1, false, false), sb = __builtin_amdgcn_permlane32_swap(b0, b1, false, false);
            u32x4 w; w.x = sa[0]; w.y = sb[0]; w.z = sa[1]; w.w = sb[1];
            *(u32x4*)(yrow + 32 * db + 16 * pr_ + 8 * hi) = w;
        }
    }
}

__device__ __forceinline__ void mixB_tile(const LAS3 unsigned char* Kb, const LAS3 unsigned char* Vt, const LAS3 float* bias, const bf16x8 (&qf)[4], f32x16& o0, f32x16& o1,
                                          float& mrun, float& lrun, bool& started, int jt, int pq, int r32, int hi) {
    f32x16 p0 = qk_block(Kb, 0, qf, r32, hi, -mrun), p1 = qk_block(Kb, 1, qf, r32, hi, -mrun);
    if (jt > 5) { const LAS3 float* bp = bias + (512 - 64 * jt + pq - 4 * hi + 128);
#pragma unroll
        for (int r = 0; r < 16; ++r) { p0[r] += bp[-((r & 3) + 8 * (r >> 2))]; p1[r] += bp[-((r & 3) + 8 * (r >> 2)) - 32]; } }
    float tm = fmaxf(p0[0], p1[0]);
#pragma unroll
    for (int r = 1; r < 16; ++r) tm = fmaxf(tm, fmaxf(p0[r], p1[r]));
    tm = fmaxf(tm, __shfl_xor(tm, 32));
    if (!started || __any(tm > 8.0f)) {
        const float delta = started ? fmaxf(tm, 0.f) : tm;
        mrun += delta;
#pragma unroll
        for (int r = 0; r < 16; ++r) { p0[r] -= delta; p1[r] -= delta; }
        if (started) { const float alpha = __builtin_amdgcn_exp2f(-delta); lrun *= alpha;
#pragma unroll
            for (int r = 0; r < 16; ++r) { o0[r] *= alpha; o1[r] *= alpha; } }
        started = true;
    }
    f32x2_t rs2 = {0.f, 0.f};
#pragma unroll
    for (int r = 0; r < 16; r += 2) { p0[r] = __builtin_amdgcn_exp2f(p0[r]); p0[r + 1] = __builtin_amdgcn_exp2f(p0[r + 1]); p1[r] = __builtin_amdgcn_exp2f(p1[r]); p1[r + 1] = __builtin_amdgcn_exp2f(p1[r + 1]);
        rs2 += (f32x2_t){p0[r], p0[r + 1]}; rs2 += (f32x2_t){p1[r], p1[r + 1]}; }
    lrun += rs2[0] + rs2[1];
    pv_block(Vt, 0, p0, o0, o1, r32, hi);
    pv_block(Vt, 1, p1, o0, o1, r32, hi);
}
__device__ __forceinline__ void mixB_pair(const LAS3 unsigned char* Ka, const LAS3 unsigned char* Va, const LAS3 unsigned char* Kb2, const LAS3 unsigned char* Vb2, const LAS3 float* bias,
                                          const bf16x8 (&qf)[4], f32x16& o0, f32x16& o1, float& mrun, float& lrun, bool& started, int jta, int pq, int r32, int hi) {
    const float init = -mrun;
    f32x16 a0 = qk_block(Ka, 0, qf, r32, hi, init), a1 = qk_block(Ka, 1, qf, r32, hi, init);
    f32x16 b0 = qk_block(Kb2, 0, qf, r32, hi, init), b1 = qk_block(Kb2, 1, qf, r32, hi, init);
    if (jta > 5) { const LAS3 float* bp = bias + (512 - 64 * jta + pq - 4 * hi + 128);
#pragma unroll
        for (int r = 0; r < 16; ++r) { a0[r] += bp[-((r & 3) + 8 * (r >> 2))]; a1[r] += bp[-((r & 3) + 8 * (r >> 2)) - 32]; } }
    if (jta + 1 > 5) { const LAS3 float* bp = bias + (512 - 64 * (jta + 1) + pq - 4 * hi + 128);
#pragma unroll
        for (int r = 0; r < 16; ++r) { b0[r] += bp[-((r & 3) + 8 * (r >> 2))]; b1[r] += bp[-((r & 3) + 8 * (r >> 2)) - 32]; } }
    float tm = fmaxf(fmaxf(a0[0], a1[0]), fmaxf(b0[0], b1[0]));
#pragma unroll
    for (int r = 1; r < 16; ++r) tm = fmaxf(tm, fmaxf(fmaxf(a0[r], a1[r]), fmaxf(b0[r], b1[r])));
    tm = fmaxf(tm, __shfl_xor(tm, 32));
    if (!started || __any(tm > 8.0f)) {
        const float delta = started ? fmaxf(tm, 0.f) : tm;
        mrun += delta;
#pragma unroll
        for (int r = 0; r < 16; ++r) { a0[r] -= delta; a1[r] -= delta; b0[r] -= delta; b1[r] -= delta; }
        if (started) { const float alpha = __builtin_amdgcn_exp2f(-delta); lrun *= alpha;
#pragma unroll
            for (int r = 0; r < 16; ++r) { o0[r] *= alpha; o1[r] *= alpha; } }
        started = true;
    }
    f32x2_t rs2 = {0.f, 0.f};
#pragma unroll
    for (int r = 0; r < 16; r += 2) { a0[r] = __builtin_amdgcn_exp2f(a0[r]); a0[r + 1] = __builtin_amdgcn_exp2f(a0[r + 1]); a1[r] = __builtin_amdgcn_exp2f(a1[r]); a1[r + 1] = __builtin_amdgcn_exp2f(a1[r + 1]);
        rs2 += (f32x2_t){a0[r], a0[r + 1]}; rs2 += (f32x2_t){a1[r], a1[r + 1]}; }
    pv_block(Va, 0, a0, o0, o1, r32, hi);
    pv_block(Va, 1, a1, o0, o1, r32, hi);
#pragma unroll
    for (int r = 0; r < 16; r += 2) { b0[r] = __builtin_amdgcn_exp2f(b0[r]); b0[r + 1] = __builtin_amdgcn_exp2f(b0[r + 1]); b1[r] = __builtin_amdgcn_exp2f(b1[r]); b1[r + 1] = __builtin_amdgcn_exp2f(b1[r + 1]);
        rs2 += (f32x2_t){b0[r], b0[r + 1]}; rs2 += (f32x2_t){b1[r], b1[r + 1]}; }
    lrun += rs2[0] + rs2[1];
    pv_block(Vb2, 0, b0, o0, o1, r32, hi);
    pv_block(Vb2, 1, b1, o0, o1, r32, hi);
}
__device__ __forceinline__ void mixB_mfma(const P& p, int l, int item, LAS3 unsigned char* lds, int tid_in) {
    int tid = tid_in; asm volatile("" : "+v"(tid));
    const int lane = tid & 63, wave = tid >> 6, r32 = lane & 31, hi = lane >> 5;
    const int h = item >> 6, C0 = (item & 63) * 4, myc = C0 + (wave >> 1), pq = (wave & 1) * 32 + r32, tokq = myc * 64 + pq;
    const bf16_t* pr = p.proj;
    const int kcol = 1280 + h * 64, vcol = 1792 + h * 64;
    const int T0 = C0 - 8 < 0 ? 0 : C0 - 8, T1 = C0 + 3;
    TileRegs tr0 = tile_load(pr, T0 * 64, kcol, vcol, tid), tr1 = tile_load(pr, (T0 + 1) * 64, kcol, vcol, tid),
             tr2 = tile_load(pr, (T0 + 2) * 64, kcol, vcol, tid), tr3 = tile_load(pr, (T0 + 3) * 64, kcol, vcol, tid);
    LAS3 float* bias = (LAS3 float*)(lds + MX_BIAS);
    LAS3 float* gainl = (LAS3 float*)(lds + MX_GAIN);
    if (tid < 64) gainl[tid] = p.out_norm_w[l * DM + 256 + h * 64 + tid];
    { const float* rb = p.rel_bias + (size_t)(l * 8 + h) * 257; const float far = rb[256];
      for (int i = tid; i < 328; i += 512) bias[i] = i < 256 ? (rb[i] - far) * LOG2E : 0.f; }
    const f32x4 gk0 = *(const f32x4*)(p.k_norm_w + l * 64 + (tid & 7) * 8), gk1 = *(const f32x4*)(p.k_norm_w + l * 64 + (tid & 7) * 8 + 4);
    bf16x8 qf[4];
    {
        u32x4 qr[4]; float ss = 0.f;
#pragma unroll
        for (int d0 = 0; d0 < 4; ++d0) { qr[d0] = *(const u32x4*)(pr + (size_t)tokq * DIN + 768 + h * 64 + 16 * d0 + 8 * hi);
            const float a0 = bflo(qr[d0].x), a1 = bfhi(qr[d0].x), a2 = bflo(qr[d0].y), a3 = bfhi(qr[d0].y), a4 = bflo(qr[d0].z), a5 = bfhi(qr[d0].z), a6 = bflo(qr[d0].w), a7 = bfhi(qr[d0].w);
            ss += ((a0 * a0 + a1 * a1) + (a2 * a2 + a3 * a3)) + ((a4 * a4 + a5 * a5) + (a6 * a6 + a7 * a7)); }
        ss += __shfl_xor(ss, 32);
        const float rs = rsqrtf(ss * (1.f / 64) + EPS) * (0.125f * LOG2E);
#pragma unroll
        for (int d0 = 0; d0 < 4; ++d0) { const float* gq = p.q_norm_w + l * 64 + 16 * d0 + 8 * hi; const f32x4 ga = *(const f32x4*)gq, gb = *(const f32x4*)(gq + 4);
            qf[d0] = pack8(bflo(qr[d0].x) * rs * ga[0], bfhi(qr[d0].x) * rs * ga[1], bflo(qr[d0].y) * rs * ga[2], bfhi(qr[d0].y) * rs * ga[3],
                           bflo(qr[d0].z) * rs * gb[0], bfhi(qr[d0].z) * rs * gb[1], bflo(qr[d0].w) * rs * gb[2], bfhi(qr[d0].w) * rs * gb[3]); }
    }
    f32x16 o0, o1;
#pragma unroll
    for (int i = 0; i < 16; ++i) { o0[i] = 0.f; o1[i] = 0.f; }
    float mrun = 0.f, lrun = 0.f; bool started = false;
#define MB_PAIR(TRA, TRB, KA, VA, KB_, VB_, TT) { LAS3 unsigned char* Ka = lds + (KA); LAS3 unsigned char* Va = lds + (VA); LAS3 unsigned char* Kb2 = lds + (KB_); LAS3 unsigned char* Vb2 = lds + (VB_); \
        tile_store<true>(TRA, Ka, Va, gk0, gk1, tid); tile_store<true>(TRB, Kb2, Vb2, gk0, gk1, tid); __syncthreads(); \
        if ((TT) + 4 <= T1) { TRA = tile_load(pr, ((TT) + 4) * 64, kcol, vcol, tid); TRB = tile_load(pr, ((TT) + 5) * 64, kcol, vcol, tid); } \
        const int jt = (TT) - (myc - 8); const bool aa = jt >= 0 && jt <= 8, ab = jt + 1 >= 0 && jt + 1 <= 8; \
        if (aa && ab) mixB_pair(Ka, Va, Kb2, Vb2, bias, qf, o0, o1, mrun, lrun, started, jt, pq, r32, hi); \
        else if (aa) mixB_tile(Ka, Va, bias, qf, o0, o1, mrun, lrun, started, jt, pq, r32, hi); \
        else if (ab) mixB_tile(Kb2, Vb2, bias, qf, o0, o1, mrun, lrun, started, jt + 1, pq, r32, hi); }
    for (int T = T0; T <= T1; T += 4) {
        MB_PAIR(tr0, tr1, MX_KB0, MX_VT0, MX_KB1, MX_VT1, T)
        MB_PAIR(tr2, tr3, MX_KB2, MX_VT2, MX_KB3, MX_VT3, T + 2)
    }
#undef MB_PAIR
    const float ltot = lrun + __shfl_xor(lrun, 32);
    finish_head(o0, o1, 1.0f / ltot, p.y + (size_t)tokq * DM + 256 + h * 64, gainl, hi);
    __syncthreads();
}

template <bool DIAG> __device__ __forceinline__ void mixA_block(const LAS3 unsigned char* Kb, const LAS3 unsigned char* Vt, int kb, const bf16x8 (&qf)[4], f32x16& o0, f32x16& o1, float& R,
                                                                int key0, int qabs, int r32, int hi) {
    const f32x16 z = qk_block(Kb, kb, qf, r32, hi);
    f32x16 E;
#pragma unroll
    for (int r = 0; r < 16; ++r) { const float az = __builtin_fabsf(z[r]);
        const float lg = __builtin_amdgcn_logf(1.0f + __builtin_amdgcn_exp2f(-az));
        float v = __builtin_fmaf(-0.5f, z[r] + az, -lg);
        if (DIAG) v = (key0 + crow(r, hi) < qabs) ? v : 0.f;
        E[r] = v; }
#pragma unroll
    for (int g = 0; g < 4; ++g) { E[4 * g + 2] += E[4 * g + 3]; E[4 * g + 1] += E[4 * g + 2]; E[4 * g] += E[4 * g + 1]; }
    float Gp[4];
#pragma unroll
    for (int g = 0; g < 4; ++g) Gp[g] = __shfl_xor(E[4 * g], 32);
    const float hm = hi == 0 ? 1.0f : 0.0f;
    float tail = R; f32x16 w;
#pragma unroll
    for (int g = 3; g >= 0; --g) {
        const float base = __builtin_fmaf(hm, Gp[g], tail);
#pragma unroll
        for (int i = 0; i < 4; ++i) { float x = __builtin_amdgcn_exp2f((z[4 * g + i] + E[4 * g + i]) + base);
            if (DIAG) x = (key0 + crow(4 * g + i, hi) < qabs) ? x : 0.f;
            w[4 * g + i] = x; }
        tail += E[4 * g] + Gp[g];
    }
    R = tail;
    pv_block(Vt, kb, w, o0, o1, r32, hi);
}
template <bool DIAG> __device__ __forceinline__ void sb_logrest(const f32x16& z, f32x16& E, int key0, int qabs, int hi) {
#pragma unroll
    for (int r = 0; r < 16; ++r) { const float az = __builtin_fabsf(z[r]);
        const float lg = __builtin_amdgcn_logf(1.0f + __builtin_amdgcn_exp2f(-az));
        float v = __builtin_fmaf(-0.5f, z[r] + az, -lg);
        if (DIAG) v = (key0 + crow(r, hi) < qabs) ? v : 0.f;
        E[r] = v; }
#pragma unroll
    for (int g = 0; g < 4; ++g) { E[4 * g + 2] += E[4 * g + 3]; E[4 * g + 1] += E[4 * g + 2]; E[4 * g] += E[4 * g + 1]; }
}
template <bool DIAG> __device__ __forceinline__ void sb_weights(const f32x16& z, const f32x16& E, const float (&Gp)[4], float Rin, f32x16& w, float hm, int key0, int qabs, int hi) {
    float tail = Rin;
#pragma unroll
    for (int g = 3; g >= 0; --g) {
        const float base = __builtin_fmaf(hm, Gp[g], tail);
#pragma unroll
        for (int i = 0; i < 4; ++i) { float x = __builtin_amdgcn_exp2f((z[4 * g + i] + E[4 * g + i]) + base);
            if (DIAG) x = (key0 + crow(4 * g + i, hi) < qabs) ? x : 0.f;
            w[4 * g + i] = x; }
        tail += E[4 * g] + Gp[g];
    }
}
template <bool D1> __device__ __forceinline__ void mixA_pair(const LAS3 unsigned char* Kb, const LAS3 unsigned char* Vt, const bf16x8 (&qf)[4], f32x16& o0, f32x16& o1, float& R,
                                                             int keyT, int qabs, int r32, int hi) {
    const f32x16 z1 = qk_block(Kb, 1, qf, r32, hi), z0 = qk_block(Kb, 0, qf, r32, hi);
    f32x16 E1, E0;
    sb_logrest<D1>(z1, E1, keyT + 32, qabs, hi);
    sb_logrest<false>(z0, E0, keyT, qabs, hi);
    float Gp1[4], Gp0[4];
#pragma unroll
    for (int g = 0; g < 4; ++g) { Gp1[g] = __shfl_xor(E1[4 * g], 32); Gp0[g] = __shfl_xor(E0[4 * g], 32); }
    float tot1 = 0.f, tot0 = 0.f;
#pragma unroll
    for (int g = 3; g >= 0; --g) { tot1 += E1[4 * g] + Gp1[g]; tot0 += E0[4 * g] + Gp0[g]; }
    const float hm = hi == 0 ? 1.0f : 0.0f, Rmid = R + tot1;
    f32x16 w1, w0;
    sb_weights<D1>(z1, E1, Gp1, R, w1, hm, keyT + 32, qabs, hi);
    sb_weights<false>(z0, E0, Gp0, Rmid, w0, hm, keyT, qabs, hi);
    R = Rmid + tot0;
    pv_block(Vt, 1, w1, o0, o1, r32, hi);
    pv_block(Vt, 0, w0, o0, o1, r32, hi);
}
__device__ __forceinline__ void mixA_tile(const LAS3 unsigned char* Kb, const LAS3 unsigned char* Vt, const bf16x8 (&qf)[4], f32x16& o0, f32x16& o1, float& R,
                                          int T, int q0w, int qabs, int r32, int hi) {
    const int keyT = 64 * T;
    if (keyT + 32 <= q0w + 30) {
        if (keyT + 63 >= q0w) mixA_pair<true>(Kb, Vt, qf, o0, o1, R, keyT, qabs, r32, hi);
        else mixA_pair<false>(Kb, Vt, qf, o0, o1, R, keyT, qabs, r32, hi);
    } else if (keyT <= q0w + 30) {
        if (keyT + 31 >= q0w) mixA_block<true>(Kb, Vt, 0, qf, o0, o1, R, keyT, qabs, r32, hi);
        else mixA_block<false>(Kb, Vt, 0, qf, o0, o1, R, keyT, qabs, r32, hi);
    }
}
constexpr float SB_THR2 = 87.0f;
__device__ __forceinline__ void mixA_mfma(const P& p, int l, int item, LAS3 unsigned char* lds, int tid_in) {
    int tid = tid_in; asm volatile("" : "+v"(tid));
    const int lane = tid & 63, wave = tid >> 6, r32 = lane & 31, hi = lane >> 5;
    const int h = item >> 6, Q0 = (item & 63) * 256, q0w = Q0 + 32 * wave, qabs = q0w + r32;
    const bf16_t* pr = p.proj;
    const int kcol = 256 + h * 64, vcol = 512 + h * 64;
    int T = Q0 / 64 + 3;
    TileRegs tr0 = tile_load(pr, T * 64, kcol, vcol, tid), tr1 = tile_load(pr, (T - 1) * 64, kcol, vcol, tid),
             tr2 = tile_load(pr, (T - 2) * 64, kcol, vcol, tid), tr3 = tile_load(pr, (T - 3) * 64, kcol, vcol, tid);
    LAS3 int* flags = (LAS3 int*)(lds + MX_FLAGS);
    LAS3 float* gainl = (LAS3 float*)(lds + MX_GAIN);
    if (tid < 64) gainl[tid] = p.out_norm_w[l * DM + h * 64 + tid];
    bf16x8 qf[4];
#pragma unroll
    for (int d0 = 0; d0 < 4; ++d0) { const u32x4 qr = *(const u32x4*)(pr + (size_t)qabs * DIN + h * 64 + 16 * d0 + 8 * hi); const float s = 0.125f * LOG2E;
        qf[d0] = pack8(bflo(qr.x) * s, bfhi(qr.x) * s, bflo(qr.y) * s, bfhi(qr.y) * s, bflo(qr.z) * s, bfhi(qr.z) * s, bflo(qr.w) * s, bfhi(qr.w) * s); }
    f32x16 o0, o1;
#pragma unroll
    for (int i = 0; i < 16; ++i) { o0[i] = 0.f; o1[i] = 0.f; }
    float R = 0.f; int done = 0;
    const f32x4 zero4 = {0.f, 0.f, 0.f, 0.f};
#define MA_STEP(TR, KOFF, VOFF, SLOT) { LAS3 unsigned char* Kb = lds + (KOFF); LAS3 unsigned char* Vt = lds + (VOFF); \
        tile_store<false>(TR, Kb, Vt, zero4, zero4, tid); if (lane == 0) flags[(SLOT) * 8 + wave] = done; __syncthreads(); \
        int alld = 1; _Pragma("unroll") for (int w = 0; w < 8; ++w) alld &= flags[(SLOT) * 8 + w]; \
        if (alld) break; \
        if (T >= 4) TR = tile_load(pr, (T - 4) * 64, kcol, vcol, tid); \
        if (!done) { mixA_tile(Kb, Vt, qf, o0, o1, R, T, q0w, qabs, r32, hi); done = __all(R < -SB_THR2) ? 1 : 0; } \
        --T; if (T < 0) break; }
    for (;;) {
        MA_STEP(tr0, MX_KB0, MX_VT0, 0) MA_STEP(tr1, MX_KB1, MX_VT1, 1) MA_STEP(tr2, MX_KB0, MX_VT0, 0) MA_STEP(tr3, MX_KB1, MX_VT1, 1)
    }
#undef MA_STEP
    finish_head(o0, o1, 1.0f, p.y + (size_t)qabs * DM + h * 64, gainl, hi);
    __syncthreads();
}

__device__ __forceinline__ void unpack8(const u32x4& u, float (&f)[8]) { f[0] = bflo(u.x); f[1] = bfhi(u.x); f[2] = bflo(u.y); f[3] = bfhi(u.y); f[4] = bflo(u.z); f[5] = bfhi(u.z); f[6] = bflo(u.w); f[7] = bfhi(u.w); }
__device__ __forceinline__ void mixC_vec4(const P& p, int l, int idx) {
    const int t0 = (idx >> 5) * 4, c = (idx & 31) * 8;
    const bf16_t* pr = p.proj; const float* cw = p.conv_w + l * 3 * 256;
    u32x4 gcr[6], xcr[6], gbr[4];
    const u32x4 z4 = {0u, 0u, 0u, 0u};
#pragma unroll
    for (int j = 0; j < 6; ++j) { const int tt = t0 - 2 + j;
        if (tt >= 0) { gcr[j] = *(const u32x4*)(pr + (size_t)tt * DIN + 2560 + c); xcr[j] = *(const u32x4*)(pr + (size_t)tt * DIN + 2816 + c); } else { gcr[j] = z4; xcr[j] = z4; } }
#pragma unroll
    for (int j = 0; j < 4; ++j) gbr[j] = *(const u32x4*)(pr + (size_t)(t0 + j) * DIN + 2304 + c);
    float w0[8], w1[8], w2[8], gn[8];
    { const f32x4 a = *(const f32x4*)(cw + c), b = *(const f32x4*)(cw + c + 4); w0[0] = a[0]; w0[1] = a[1]; w0[2] = a[2]; w0[3] = a[3]; w0[4] = b[0]; w0[5] = b[1]; w0[6] = b[2]; w0[7] = b[3]; }
    { const f32x4 a = *(const f32x4*)(cw + 256 + c), b = *(const f32x4*)(cw + 256 + c + 4); w1[0] = a[0]; w1[1] = a[1]; w1[2] = a[2]; w1[3] = a[3]; w1[4] = b[0]; w1[5] = b[1]; w1[6] = b[2]; w1[7] = b[3]; }
    { const f32x4 a = *(const f32x4*)(cw + 512 + c), b = *(const f32x4*)(cw + 512 + c + 4); w2[0] = a[0]; w2[1] = a[1]; w2[2] = a[2]; w2[3] = a[3]; w2[4] = b[0]; w2[5] = b[1]; w2[6] = b[2]; w2[7] = b[3]; }
    { const float* g = p.out_norm_w + l * DM + 768 + c; const f32x4 a = *(const f32x4*)g, b = *(const f32x4*)(g + 4); gn[0] = a[0]; gn[1] = a[1]; gn[2] = a[2]; gn[3] = a[3]; gn[4] = b[0]; gn[5] = b[1]; gn[6] = b[2]; gn[7] = b[3]; }
    float hc[6][8];
#pragma unroll
    for (int j = 0; j < 6; ++j) { float a[8], b[8]; unpack8(gcr[j], a); unpack8(xcr[j], b);
#pragma unroll
        for (int e = 0; e < 8; ++e) hc[j][e] = a[e] * b[e]; }
#pragma unroll
    for (int j = 0; j < 4; ++j) { float gb[8], y[8]; unpack8(gbr[j], gb); float ss = 0.f;
#pragma unroll
        for (int e = 0; e < 8; ++e) { float acc = w0[e] * hc[j][e]; acc += w1[e] * hc[j + 1][e]; acc += w2[e] * hc[j + 2][e]; y[e] = gb[e] * acc; ss += y[e] * y[e]; }
        ss += __shfl_xor(ss, 1); ss += __shfl_xor(ss, 2); ss += __shfl_xor(ss, 4);
        const float f = rsqrtf(ss * (1.f / 64) + EPS);
        u32x4 o; o.x = pk_bf16(y[0] * f * gn[0], y[1] * f * gn[1]); o.y = pk_bf16(y[2] * f * gn[2], y[3] * f * gn[3]);
        o.z = pk_bf16(y[4] * f * gn[4], y[5] * f * gn[5]); o.w = pk_bf16(y[6] * f * gn[6], y[7] * f * gn[7]);
        *(u32x4*)(p.y + (size_t)(t0 + j) * DM + 768 + c) = o; }
}

#define LAS __attribute__((address_space(3)))
#define XB_TMO      128
#define XB_XCNT(j)  (256  + 64 * (j))
#define XB_XSUB(j)  (1280 + 64 * (j))
#define XB_XGEN(j)  (2304 + 64 * (j))
#define XB_TOP      3328
#define XB_TOPGEN   3392
#define XCD_BAR_WORDS 3456
#define XB_SPIN_CAP (1u << 18)

__device__ __forceinline__ unsigned xb_ld(unsigned* p)              { return __hip_atomic_load(p, __ATOMIC_RELAXED, __HIP_MEMORY_SCOPE_AGENT); }
__device__ __forceinline__ unsigned xb_add(unsigned* p, unsigned v) { return __hip_atomic_fetch_add(p, v, __ATOMIC_RELAXED, __HIP_MEMORY_SCOPE_AGENT); }
__device__ __forceinline__ unsigned xb_xcc_id() { return (unsigned)__builtin_amdgcn_s_getreg((3 << 11) | 20) & 0xFu; }
#define XB_SPIN(cond, bar) do { unsigned _sp = 0; while (cond) { __builtin_amdgcn_s_sleep(1); \
    if ((++_sp & 255u) == 0u) { if (xb_ld(&(bar)[XB_TMO])) break; if (_sp > XB_SPIN_CAP) { atomicAdd(&(bar)[XB_TMO], 1u); break; } } } } while (0)

struct XcdBarrier {
    unsigned* bar; unsigned x;
    volatile LAS unsigned* st;
};

__device__ __forceinline__ XcdBarrier xcd_barrier_post(unsigned* bar, volatile LAS unsigned* st) {
    XcdBarrier b; b.bar = bar; b.x = xb_xcc_id(); b.st = st;
    if (threadIdx.x == 0) (void)xb_add(&bar[XB_XCNT(b.x)], 1u);
    return b;
}
__device__ __forceinline__ void xcd_barrier_complete(unsigned* bar, unsigned x, unsigned& nloc, unsigned& nx) {
    const unsigned G = gridDim.x * gridDim.y * gridDim.z;
    unsigned sum, cnt, mine, sp = 0u;
    for (;;) {
        sum = 0u; cnt = 0u; mine = 0u;
#pragma unroll
        for (unsigned j = 0; j < 16; ++j) { const unsigned c = xb_ld(&bar[XB_XCNT(j)]); sum += c; cnt += (c > 0u) ? 1u : 0u; mine = (j == x) ? c : mine; }
        if (sum == G) break;
        __builtin_amdgcn_s_sleep(1);
        if ((++sp & 255u) == 0u) { if (xb_ld(&bar[XB_TMO])) break; if (sp > XB_SPIN_CAP) { atomicAdd(&bar[XB_TMO], 1u); break; } }
    }
    nloc = mine > 0u ? mine : 1u; nx = cnt > 0u ? cnt : 1u;
}

__device__ __forceinline__ void xcd_barrier(const XcdBarrier& b) {
    asm volatile("s_waitcnt vmcnt(0)" ::: "memory");
    __syncthreads();
    if (threadIdx.x == 0) {
        unsigned* bar = b.bar;
        __builtin_amdgcn_s_waitcnt(0);
        unsigned nloc = b.st[0], nx = b.st[1];
        if (nloc == 0u) { xcd_barrier_complete(bar, b.x, nloc, nx); b.st[0] = nloc; b.st[1] = nx; }
        const unsigned old = xb_add(&bar[XB_XSUB(b.x)], 1u);
        const unsigned gen = old / nloc;
        if (old + 1u == (gen + 1u) * nloc) {
            __builtin_amdgcn_fence(__ATOMIC_RELEASE, "agent");
            asm volatile("s_waitcnt vmcnt(0)" ::: "memory");
            const unsigned og = xb_add(&bar[XB_TOP], 1u);
            const unsigned tg = og / nx;
            if (og + 1u == (tg + 1u) * nx) xb_add(&bar[XB_TOPGEN], 1u);
            else XB_SPIN(xb_ld(&bar[XB_TOPGEN]) == tg, bar);
            __builtin_amdgcn_fence(__ATOMIC_ACQUIRE, "agent");
            xb_add(&bar[XB_XGEN(b.x)], 1u);
            asm volatile("s_waitcnt vmcnt(0)" ::: "memory");
        } else {
            XB_SPIN(xb_ld(&bar[XB_XGEN(b.x)]) == gen, bar);
            __builtin_amdgcn_fence(__ATOMIC_ACQUIRE, "agent");
            asm volatile("s_waitcnt vmcnt(0)" ::: "memory");
        }
    }
    __syncthreads();
}

constexpr int LDS_BYTES = 147456;
__global__ void __launch_bounds__(512, 2) fwd(P p) {
    extern __shared__ __attribute__((aligned(16))) unsigned char lds[];
    cg::grid_group grid = cg::this_grid();
    const int tid = threadIdx.x, lane = tid & 63, wave = __builtin_amdgcn_readfirstlane(tid >> 6);
    const int G = gridDim.x, gw = blockIdx.x * 8 + wave, NGW = G * 8;
    LAS3 unsigned char* lds3 = (LAS3 unsigned char*)lds;
    if (tid < 64) ((LAS3 unsigned*)(lds3 + 131072))[tid] = 0u;
    __syncthreads();
    XcdBarrier bar = xcd_barrier_post(p.ctl, (volatile LAS3 unsigned*)(lds3 + 131072));
    for (int it = gw; it < T_LAYER; it += NGW) conv_item(p, it, (LAS3 float*)(lds3 + wave * 8448), lane);
    for (int row = gw; row < S; row += 4 * NGW) {
        f32x4 v[4][4]; float ssq[4];
#pragma unroll
        for (int q = 0; q < 4; ++q) { const int r = row + q * NGW < S ? row + q * NGW : row; const f32x4* xr = (const f32x4*)(p.x + (size_t)r * DM) + lane;
#pragma unroll
            for (int j = 0; j < 4; ++j) v[q][j] = xr[64 * j]; }
#pragma unroll
        for (int q = 0; q < 4; ++q) { float a = 0.f;
#pragma unroll
            for (int j = 0; j < 4; ++j) a += (v[q][j].x * v[q][j].x + v[q][j].y * v[q][j].y) + (v[q][j].z * v[q][j].z + v[q][j].w * v[q][j].w);
            ssq[q] = a; }
#pragma unroll
        for (int o = 1; o < 64; o <<= 1) {
#pragma unroll
            for (int q = 0; q < 4; ++q) ssq[q] += __shfl_xor(ssq[q], o); }
#pragma unroll
        for (int q = 0; q < 4; ++q) { const int r = row + q * NGW; if (r < S) {
            unsigned long long* o8 = (unsigned long long*)(p.xb + (size_t)r * DM) + lane;
#pragma unroll
            for (int j = 0; j < 4; ++j) o8[64 * j] = (unsigned long long)(f2bf(v[q][j].x) | (f2bf(v[q][j].y) << 16)) | ((unsigned long long)(f2bf(v[q][j].z) | (f2bf(v[q][j].w) << 16)) << 32);
            if (lane < 16) p.rowss[(size_t)r * 16 + lane] = lane == 0 ? ssq[q] : 0.f; } }
    }
    if (p.use_cg_sync) grid.sync();
    GSYNC();
    const bool use_tab = (G % 8 == 0);
    LAS3 float* rstd_tab = (LAS3 float*)(lds3 + 131072 + 2048);
    const int tab_row0 = 2048 * ((int)blockIdx.x % 8);
#define FILL_RSTD_TAB() do { if (use_tab) { int t_ = tid; asm volatile("" : "+v"(t_)); \
        for (int r = t_; r < 2048; r += 512) { const f32x4* q = (const f32x4*)(p.rowss + (size_t)(tab_row0 + r) * 16); const f32x4 a = q[0], b = q[1], c = q[2], d = q[3]; \
            const float sm = (((a[0] + a[1]) + (a[2] + a[3])) + ((b[0] + b[1]) + (b[2] + b[3]))) + (((c[0] + c[1]) + (c[2] + c[3])) + ((d[0] + d[1]) + (d[2] + d[3]))); \
            rstd_tab[r] = rsqrtf(sm * (1.0f / DM) + EPS); } \
        __syncthreads(); } } while (0)
    for (int l = 0; l < DEPTH; ++l) {
        {
            pg8::Gemm g{p.xb, p.wt_in + (size_t)l * DIN * DM, S, DIN, DM}; pg8::StaticOrder so; so.init(S, DIN, G, (int)blockIdx.x);
            FILL_RSTD_TAB();
            pg8::EpiProj E{p.proj, p.rowss, use_tab ? rstd_tab : nullptr, tab_row0};
            pg8::gemm_phase<pg8::EpiProj, pg8::StaticOrder, true, true>(lds3, g, so, E);
        }
        GSYNC();
        {
            if (G == 256) {
                const int x = (int)blockIdx.x % 8, j = (int)blockIdx.x / 8, pmx = 8 * x + (j >> 2), hh = j & 3;
                mixA_mfma(p, l, hh * 64 + pmx, lds3, tid);
                mixB_mfma(p, l, hh * 64 + pmx, lds3, tid);
                mixB_mfma(p, l, (hh + 4) * 64 + pmx, lds3, tid);
                { int tc = tid; asm volatile("" : "+v"(tc)); mixC_vec4(p, l, (512 * x + 16 * j) * 32 + tc); }
            } else {
            const int vcu = (G % 8 == 0) ? ((int)blockIdx.x % 8) * (G / 8) + (int)blockIdx.x / 8 : (int)blockIdx.x;
            for (int it = vcu; it < 256; it += G) mixA_mfma(p, l, it, lds3, tid);
            for (int it = vcu; it < 512; it += G) mixB_mfma(p, l, it, lds3, tid);
            { int tc = tid; asm volatile("" : "+v"(tc));
              for (int idx = (int)blockIdx.x * 512 + tc; idx < S * 8; idx += G * 512) mixC_vec4(p, l, idx); }
            }
        }
        GSYNC();
        {
            pg8::Gemm g{p.y, p.wt_out + (size_t)l * DM * DM, S, DM, DM}; pg8::StaticOrder so; so.init(S, DM, G, (int)blockIdx.x);
            pg8::EpiResidB E{nullptr, nullptr, p.xb, p.rowss};
            pg8::gemm_phase<pg8::EpiResidB, pg8::StaticOrder, true, true>(lds3, g, so, E);
        }
        GSYNC();
        {
            pg8::Gemm g{p.xb, p.wt_gu + (size_t)l * 2 * DFF * DM, S, 2 * DFF, DM}; pg8::StaticOrder so; so.init(S, 2 * DFF, G, (int)blockIdx.x);
            FILL_RSTD_TAB();
            pg8::EpiSwiglu E{p.hid, p.rowss, use_tab ? rstd_tab : nullptr, tab_row0};
            pg8::gemm_phase<pg8::EpiSwiglu, pg8::StaticOrder, true, true>(lds3, g, so, E);
            if (l + 1 < DEPTH) {
                const int nwg = (S / 256) * (2 * DFF / 256), rem = nwg % G, first = rem == 0 ? 0 : rem, nidle = G - first;
                if ((int)blockIdx.x >= first) {
                    int wv = wave, ln = lane; asm volatile("" : "+s"(wv), "+v"(ln));
                    for (int it = ((int)blockIdx.x - first) * 8 + wv; it < T_LAYER; it += nidle * 8) conv_item(p, (l + 1) * T_LAYER + it, (LAS3 float*)(lds3 + wv * 8448), ln);
                }
            }
        }
        GSYNC();
        {
            pg8::Gemm g{p.hid, p.wt_dn + (size_t)l * DM * DFF, S, DM, DFF}; pg8::StaticOrder so; so.init(S, DM, G, (int)blockIdx.x);
            pg8::EpiResidB E{nullptr, l + 1 < DEPTH ? nullptr : p.out, p.xb, p.rowss};
            pg8::gemm_phase<pg8::EpiResidB, pg8::StaticOrder, true, true>(lds3, g, so, E);
        }
        if (l + 1 < DEPTH) GSYNC();
    }
}

extern "C" void kernel_launch(void* const* d_in, const int* in_sizes, int n_in, void* d_out, int out_size, void* d_ws, size_t ws_size, hipStream_t stream) {
    if (ws_size < WS_END) { fprintf(stderr, "ws too small: %zu < %zu\n", ws_size, (size_t)WS_END); return; }
    static int grid_blocks = 0;
    if (!grid_blocks) {
        int dev = 0, cus = 0, per_cu = 0;
        hipGetDevice(&dev);
        hipDeviceGetAttribute(&cus, hipDeviceAttributeMultiprocessorCount, dev);
        hipFuncSetAttribute((const void*)fwd, hipFuncAttributeMaxDynamicSharedMemorySize, LDS_BYTES);
        hipOccupancyMaxActiveBlocksPerMultiprocessor(&per_cu, (const void*)fwd, 512, LDS_BYTES);
        if (per_cu < 1) { fprintf(stderr, "occupancy query says %d blocks/CU\n", per_cu); per_cu = 1; }
        (void)hipGetLastError();
        grid_blocks = cus * per_cu;
    }
    P p{};
    p.x = (const float*)d_in[0]; p.attn_norm_w = (const float*)d_in[1]; p.w_in = (const float*)d_in[2]; p.q_norm_w = (const float*)d_in[3];
    p.k_norm_w = (const float*)d_in[4]; p.rel_bias = (const float*)d_in[5]; p.conv_w = (const float*)d_in[6]; p.out_norm_w = (const float*)d_in[7];
    p.w_out = (const float*)d_in[8]; p.ffn_norm_w = (const float*)d_in[9]; p.w_gate = (const float*)d_in[10]; p.w_up = (const float*)d_in[11];
    p.w_down = (const float*)d_in[12];
    p.out = (float*)d_out;
    char* ws = (char*)d_ws;
    p.wt_in = (bf16_t*)(ws + WS_WIN); p.wt_out = (bf16_t*)(ws + WS_WOUT); p.wt_gu = (bf16_t*)(ws + WS_WGU); p.wt_dn = (bf16_t*)(ws + WS_WDN);
    p.xb = (bf16_t*)(ws + WS_XB); p.y = (bf16_t*)(ws + WS_Y); p.rowss = (float*)(ws + WS_RSS); p.proj = (bf16_t*)(ws + WS_PROJ); p.hid = p.proj; p.ctl = (unsigned*)(ws + WS_CTL);
    if (hipMemsetAsync(ws + WS_CTL, 0, CTL_BYTES, stream) != hipSuccess) { fprintf(stderr, "memset failed\n"); return; }
    void* args[] = {&p};
    hipError_t e = hipLaunchCooperativeKernel((const void*)fwd, dim3(grid_blocks), dim3(512), args, LDS_BYTES, stream);
    if (e != hipSuccess) fprintf(stderr, "cooperative launch failed: %s (grid %d)\n", hipGetErrorString(e), grid_blocks);
}
```
